# Optimizing an MI355X kernel written in HIP

```python
import math
import jax, jax.numpy as jnp
from jax import lax
import numpy as np

D_MODEL = 2048
BATCH = 8
SEQ = 2048
DEPTH = 1

EPS = 1e-6
D_MIX = D_MODEL
RET_HEADS = 8
RET_DV = D_MIX // (2 * RET_HEADS)
RET_DK = RET_DV // 2
RET_CHUNK = 128
RET_W = RET_HEADS * RET_DV
NSA_HEADS = 8
NSA_GROUPS = 2
NSA_HPG = NSA_HEADS // NSA_GROUPS
NSA_DH = D_MIX // (2 * NSA_HEADS)
NSA_W = NSA_HEADS * NSA_DH
KV_W = NSA_GROUPS * NSA_DH
CMP_LEN = 32
CMP_STRIDE = 16
CMP_HIDDEN = 2 * NSA_DH
SEL_BLOCK = 64
SEL_TOPK = 16
SEL_QCHUNK = 32
WINDOW = 512
WIN_QBLOCK = 128
N_BUCKETS = 32
MAX_DISTANCE = 128
PEER_HEADS = 8
PEER_NKEYS = 128
PEER_N = PEER_NKEYS * PEER_NKEYS
PEER_DQ = 256
PEER_TOPK = 16
PEER_TOKCHUNK = 128
SPLITS = (RET_HEADS * RET_DK, RET_HEADS * RET_DK, RET_W, RET_W, NSA_W, 6 * KV_W, 3 * NSA_HEADS)
IN_COLS = 2 * RET_HEADS * RET_DK + 2 * RET_W + NSA_W + 6 * KV_W + 3 * NSA_HEADS

kernel_name = 'hybrid_retnet_nsa_peer'


def rms_normalize(x):
    xf = x.astype(jnp.float32)
    return (xf * lax.rsqrt(jnp.mean(xf * xf, axis=-1, keepdims=True) + EPS)).astype(x.dtype)


def rmsnorm(x, g):
    return rms_normalize(x) * g


def masked_softmax(s, mask):
    s = jnp.where(mask, s.astype(jnp.float32), -1e30)
    m = jnp.max(s, axis=-1, keepdims=True)
    e = jnp.exp(s - m) * mask
    return e / jnp.maximum(jnp.sum(e, axis=-1, keepdims=True), 1e-30)


def t5_bucket(dist):
    dist = jnp.maximum(dist, 0)
    max_exact = N_BUCKETS // 2
    log_ratio = jnp.log(jnp.maximum(dist, 1).astype(jnp.float32) / max_exact) / math.log(MAX_DISTANCE / max_exact)
    large = jnp.minimum(max_exact + (log_ratio * (N_BUCKETS - max_exact)).astype(jnp.int32), N_BUCKETS - 1)
    return jnp.where(dist < max_exact, dist, large)


def rotary(x, pos):
    half = x.shape[-1] // 2
    inv = 1.0 / (10000.0 ** (jnp.arange(half, dtype=jnp.float32) / half))
    ang = pos.astype(jnp.float32)[:, None] * inv[None, :]
    cos = jnp.cos(ang)[None, :, None, :].astype(x.dtype)
    sin = jnp.sin(ang)[None, :, None, :].astype(x.dtype)
    x1, x2 = x[..., :half], x[..., half:]
    return jnp.concatenate([x1 * cos - x2 * sin, x1 * sin + x2 * cos], axis=-1)


def retention_chunkwise(q, k, v):
    B, T, H, dk = q.shape
    dv = v.shape[-1]
    C = RET_CHUNK
    nc = T // C
    q = q.astype(jnp.float32) * dk ** -0.5
    k = k.astype(jnp.float32)
    v = v.astype(jnp.float32)
    log_g = jnp.log(1.0 - 2.0 ** (-5.0 - jnp.arange(H, dtype=jnp.float32)))
    qc = q.reshape(B, nc, C, H, dk)
    kc = k.reshape(B, nc, C, H, dk)
    vc = v.reshape(B, nc, C, H, dv)
    idx = jnp.arange(C, dtype=jnp.float32)
    diff = idx[:, None] - idx[None, :]
    dmask = jnp.where(diff >= 0, jnp.exp(log_g[:, None, None] * jnp.maximum(diff, 0.0)), 0.0)
    s = jnp.einsum('bcnhd,bcmhd->bchnm', qc, kc) * dmask
    intra = jnp.einsum('bchnm,bcmhe->bcnhe', s, vc)
    zeta = jnp.exp(log_g[:, None] * (C - 1 - idx)[None, :])
    xi = jnp.exp(log_g[:, None] * (idx + 1.0)[None, :])
    kv = jnp.einsum('bcmhd,hm,bcmhe->bchde', kc, zeta, vc)
    decay_c = jnp.exp(log_g * C)[None, :, None, None]

    def step(state, kv_c):
        return state * decay_c + kv_c, state

    _, r_prev = lax.scan(step, jnp.zeros((B, H, dk, dv), jnp.float32), jnp.moveaxis(kv, 1, 0))
    r_prev = jnp.moveaxis(r_prev, 0, 1)
    cross = jnp.einsum('bcnhd,bchde,hn->bcnhe', qc, r_prev, xi)
    return (intra + cross).reshape(B, T, H, dv)


def retention_group(rq, rk, rv, rg, gn_g, pos):
    B, T, _ = rq.shape
    q = rotary(rq.reshape(B, T, RET_HEADS, RET_DK), pos)
    k = rotary(rk.reshape(B, T, RET_HEADS, RET_DK), pos)
    v = rv.reshape(B, T, RET_HEADS, RET_DV)
    y = retention_chunkwise(q, k, v)
    mu = jnp.mean(y, axis=-1, keepdims=True)
    var = jnp.mean(jnp.square(y - mu), axis=-1, keepdims=True)
    y = ((y - mu) * lax.rsqrt(var + EPS)).reshape(B, T, RET_W).astype(rg.dtype) * gn_g
    return jax.nn.silu(rg) * y


def compress(a, pe, w1, w2):
    B, T, G, dh = a.shape
    nc = (T - CMP_LEN) // CMP_STRIDE + 1
    idx = jnp.arange(nc)[:, None] * CMP_STRIDE + jnp.arange(CMP_LEN)[None, :]
    blk = a[:, idx] + pe[:, None, :]
    blk = jnp.moveaxis(blk, 3, 2).reshape(B, nc, G, CMP_LEN * dh)
    return jax.nn.gelu(blk @ w1) @ w2


def cmp_attention(q, kc, vc, rb):
    T = q.shape[1]
    nc = kc.shape[1]
    s = jnp.einsum('btghd,bcgd->bghtc', q, kc)
    end = jnp.arange(nc) * CMP_STRIDE + CMP_LEN - 1
    dist = jnp.arange(T)[:, None] - end[None, :]
    bias = jnp.moveaxis(rb[t5_bucket(dist)], (2, 3), (0, 1))
    p = masked_softmax(s + bias, dist >= 0)
    o = jnp.einsum('bghtc,bcgd->btghd', p.astype(vc.dtype), vc)
    return o, p


def sel_attention(q, k, v, p_cmp, rb):
    B, T = q.shape[:2]
    nsel = T // SEL_BLOCK
    nc = p_cmp.shape[-1]
    topk = min(SEL_TOPK, nsel)
    cs = jnp.arange(nc) * CMP_STRIDE
    js = jnp.arange(nsel) * SEL_BLOCK
    overlap = jnp.clip(jnp.minimum(cs[:, None] + CMP_LEN, js[None, :] + SEL_BLOCK) - jnp.maximum(cs[:, None], js[None, :]), 0, None).astype(jnp.float32) / CMP_LEN
    imp = jnp.einsum('bghtc,cj->bgtj', p_cmp, overlap)
    t = jnp.arange(T)
    j = jnp.arange(nsel)
    cur = t // SEL_BLOCK
    causal = j[None, :] * SEL_BLOCK <= t[:, None]
    forced = (j[None, :] == 0) | (j[None, :] == cur[:, None]) | (j[None, :] == cur[:, None] - 1)
    imp = jnp.where(forced, 1e9, imp)
    imp = jnp.where(causal, imp, -1e9)
    vals, idx = lax.top_k(imp, topk)
    sel_ok = vals > -1e8
    kb = jnp.moveaxis(k.reshape(B, nsel, SEL_BLOCK, NSA_GROUPS, NSA_DH), 3, 1)
    vb = jnp.moveaxis(v.reshape(B, nsel, SEL_BLOCK, NSA_GROUPS, NSA_DH), 3, 1)
    nq = T // SEL_QCHUNK
    qs = jnp.moveaxis(q.reshape(B, nq, SEL_QCHUNK, NSA_GROUPS, NSA_HPG, NSA_DH), 1, 0)
    idx_s = jnp.moveaxis(idx.reshape(B, NSA_GROUPS, nq, SEL_QCHUNK, topk), 2, 0)
    ok_s = jnp.moveaxis(sel_ok.reshape(B, NSA_GROUPS, nq, SEL_QCHUNK, topk), 2, 0)
    bi = jnp.arange(B)[:, None, None, None]
    gi = jnp.arange(NSA_GROUPS)[None, :, None, None]
    gi5 = gi[..., None]
    sb = jnp.arange(SEL_BLOCK)
    n_keys = topk * SEL_BLOCK

    def chunk(args):
        qc, ic, okc, t0 = args
        kg = kb[bi, gi, ic]
        vg = vb[bi, gi, ic]
        tq = t0 + jnp.arange(SEL_QCHUNK)
        kpos = ic[..., None] * SEL_BLOCK + sb
        dist = tq[:, None, None] - kpos
        mask = okc[..., None] & (dist >= 0)
        bias = jnp.moveaxis(rb[t5_bucket(dist), gi5], -1, 2)
        s = jnp.einsum('btghd,bgtksd->bghtks', qc, kg) + bias
        p = masked_softmax(s.reshape(B, NSA_GROUPS, NSA_HPG, SEL_QCHUNK, n_keys), mask.reshape(B, NSA_GROUPS, 1, SEL_QCHUNK, n_keys))
        return jnp.einsum('bghtn,bgtnd->btghd', p.astype(vg.dtype), vg.reshape(B, NSA_GROUPS, SEL_QCHUNK, n_keys, NSA_DH))

    o = lax.map(chunk, (qs, idx_s, ok_s, jnp.arange(nq) * SEL_QCHUNK))
    return jnp.moveaxis(o, 0, 1).reshape(B, T, NSA_GROUPS, NSA_HPG, NSA_DH)


def win_attention(q, k, v, rb):
    B, T = q.shape[:2]
    nb = T // WIN_QBLOCK
    nwin = WINDOW // WIN_QBLOCK + 1
    K = nwin * WIN_QBLOCK
    widx = jnp.arange(nb)[:, None] + jnp.arange(nwin)[None, :]

    def band(a):
        ap = jnp.pad(a, ((0, 0), (WINDOW, 0), (0, 0), (0, 0))).reshape(B, nb + nwin - 1, WIN_QBLOCK, NSA_GROUPS, NSA_DH)
        return jnp.moveaxis(ap[:, widx].reshape(B, nb, K, NSA_GROUPS, NSA_DH), 1, 0)

    kw, vw = band(k), band(v)
    qb = jnp.moveaxis(q.reshape(B, nb, WIN_QBLOCK, NSA_GROUPS, NSA_HPG, NSA_DH), 1, 0)
    ki = jnp.arange(K)
    dist = WINDOW + jnp.arange(WIN_QBLOCK)[:, None] - ki[None, :]
    in_band = (dist >= 0) & (dist < WINDOW)
    bias = jnp.moveaxis(rb[t5_bucket(dist)], (2, 3), (0, 1))

    def block(args):
        qn, kn, vn, n = args
        kpos = n * WIN_QBLOCK - WINDOW + ki
        mask = in_band & (kpos >= 0)[None, :]
        s = jnp.einsum('bqghd,bkgd->bghqk', qn, kn) + bias
        p = masked_softmax(s, mask)
        return jnp.einsum('bghqk,bkgd->bqghd', p.astype(vn.dtype), vn)

    o = lax.map(block, (qb, kw, vw, jnp.arange(nb)))
    return jnp.moveaxis(o, 0, 1).reshape(B, T, NSA_GROUPS, NSA_HPG, NSA_DH)


def nsa_group(nq, nkv, ngate, rel_bias, cmp_pe, cmp_w1, cmp_w2, out_g):
    B, T, _ = nq.shape
    q = nq.reshape(B, T, NSA_GROUPS, NSA_HPG, NSA_DH) * NSA_DH ** -0.5
    kv = nkv.reshape(B, T, 6, NSA_GROUPS, NSA_DH)
    rb = rel_bias.reshape(N_BUCKETS, NSA_GROUPS, NSA_HPG)
    k_cmp = compress(kv[:, :, 0], cmp_pe[0], cmp_w1[0], cmp_w2[0])
    v_cmp = compress(kv[:, :, 1], cmp_pe[1], cmp_w1[1], cmp_w2[1])
    o_cmp, p_cmp = cmp_attention(q, k_cmp, v_cmp, rb)
    o_sel = sel_attention(q, kv[:, :, 2], kv[:, :, 3], p_cmp, rb)
    o_win = win_attention(q, kv[:, :, 4], kv[:, :, 5], rb)
    gate = jax.nn.sigmoid(ngate.reshape(B, T, NSA_GROUPS, NSA_HPG, 3))
    o = gate[..., 0:1] * o_cmp + gate[..., 1:2] * o_sel + gate[..., 2:3] * o_win
    return rms_normalize(o).reshape(B, T, NSA_W) * out_g


def peer_ffn(x, wq, subkeys, u, v):
    B, T, D = x.shape
    n = B * T
    xt = x.reshape(n, D)
    q = (xt @ wq).reshape(n, PEER_HEADS, 2, PEER_DQ // 2)
    s = jnp.einsum('nhpd,pkd->nhpk', q, subkeys)
    sv, si = lax.top_k(s, PEER_TOPK)
    cand = sv[:, :, 0, :, None] + sv[:, :, 1, None, :]
    cidx = si[:, :, 0, :, None] * PEER_NKEYS + si[:, :, 1, None, :]
    cs, ci = lax.top_k(cand.reshape(n, PEER_HEADS, PEER_TOPK * PEER_TOPK), PEER_TOPK)
    eidx = jnp.take_along_axis(cidx.reshape(n, PEER_HEADS, PEER_TOPK * PEER_TOPK), ci, axis=-1)
    gate = jax.nn.softmax(cs.astype(jnp.float32), axis=-1).astype(x.dtype)
    nch = n // PEER_TOKCHUNK

    def chunk(args):
        xc, ec, gc = args
        hid = jax.nn.gelu(jnp.einsum('cd,chkd->chk', xc, u[ec]))
        return jnp.einsum('chk,chkd->cd', gc * hid, v[ec])

    out = lax.map(chunk, (xt.reshape(nch, PEER_TOKCHUNK, D), eidx.reshape(nch, PEER_TOKCHUNK, PEER_HEADS, PEER_TOPK), gate.reshape(nch, PEER_TOKCHUNK, PEER_HEADS, PEER_TOPK)))
    return out.reshape(B, T, D)


def setup_inputs(seed: int = 0) -> dict:
    key = jax.random.key(seed)
    ks = jax.random.split(key, 16)
    nrm = jax.random.normal
    f32 = jnp.float32
    return {
        'x': nrm(ks[0], (BATCH, SEQ, D_MODEL), f32),
        'norm1_g': 1.0 + 0.02 * nrm(ks[1], (DEPTH, D_MODEL), f32),
        'w_in': nrm(ks[2], (DEPTH, D_MODEL, IN_COLS), f32) * D_MODEL ** -0.5,
        'rel_bias': 0.5 * nrm(ks[3], (N_BUCKETS, NSA_HEADS), f32),
        'ret_gn_g': 1.0 + 0.02 * nrm(ks[4], (DEPTH, RET_W), f32),
        'cmp_pe': 0.2 * nrm(ks[5], (DEPTH, 2, CMP_LEN, NSA_DH), f32),
        'cmp_w1': nrm(ks[6], (DEPTH, 2, CMP_LEN * NSA_DH, CMP_HIDDEN), f32) * (CMP_LEN * NSA_DH) ** -0.5,
        'cmp_w2': nrm(ks[7], (DEPTH, 2, CMP_HIDDEN, NSA_DH), f32) * CMP_HIDDEN ** -0.5,
        'nsa_out_g': 1.0 + 0.02 * nrm(ks[8], (DEPTH, NSA_W), f32),
        'w_out': nrm(ks[9], (DEPTH, D_MIX, D_MODEL), f32) * D_MIX ** -0.5,
        'norm2_g': 1.0 + 0.02 * nrm(ks[10], (DEPTH, D_MODEL), f32),
        'peer_wq': nrm(ks[11], (DEPTH, D_MODEL, PEER_HEADS * PEER_DQ), f32) * D_MODEL ** -0.5,
        'peer_subkeys': nrm(ks[12], (DEPTH, 2, PEER_NKEYS, PEER_DQ // 2), f32) * (PEER_DQ // 2) ** -0.5,
        'peer_u': nrm(ks[13], (DEPTH, PEER_N, D_MODEL), f32) * D_MODEL ** -0.5,
        'peer_v': 0.5 * nrm(ks[14], (DEPTH, PEER_N, D_MODEL), f32),
        'norm_f_g': 1.0 + 0.02 * nrm(ks[15], (D_MODEL,), f32),
    }


def reference(x, norm1_g, w_in, rel_bias, ret_gn_g, cmp_pe, cmp_w1, cmp_w2, nsa_out_g, w_out, norm2_g, peer_wq, peer_subkeys, peer_u, peer_v, norm_f_g):
    T = x.shape[1]
    pos = jnp.arange(T)
    offsets = [int(o) for o in np.cumsum(SPLITS)[:-1]]
    h = x
    for l in range(DEPTH):
        xn = rmsnorm(h, norm1_g[l])
        proj = xn @ w_in[l]
        rq, rk, rv, rg, nq, nkv, ngate = jnp.split(proj, offsets, axis=-1)
        ret = retention_group(rq, rk, rv, rg, ret_gn_g[l], pos)
        nsa = nsa_group(nq, nkv, ngate, rel_bias, cmp_pe[l], cmp_w1[l], cmp_w2[l], nsa_out_g[l])
        h = h + jnp.concatenate([ret, nsa], axis=-1) @ w_out[l]
        h = h + peer_ffn(rmsnorm(h, norm2_g[l]), peer_wq[l], peer_subkeys[l], peer_u[l], peer_v[l])
    return rmsnorm(h, norm_f_g)
```

```cpp
#include <hip/hip_runtime.h>
#include <hip/hip_cooperative_groups.h>
#include <cstdio>
#include <cstdint>
namespace cg = cooperative_groups;
#ifndef PB
#define PB 4
#endif
#ifndef N_LAUNCHES
#define N_LAUNCHES 1
#endif
__device__ __forceinline__ int lane_now() { int ln; asm volatile("v_mbcnt_lo_u32_b32 %0, -1, 0\n\tv_mbcnt_hi_u32_b32 %0, -1, %0" : "=v"(ln)); return ln; }
namespace pg8 {
#define PG8_LAS __attribute__((address_space(3)))
typedef unsigned short bf16_t;
typedef short bf16x8 __attribute__((ext_vector_type(8)));
typedef float f32x4 __attribute__((ext_vector_type(4)));
typedef unsigned u32x4 __attribute__((ext_vector_type(4)));
constexpr int BM = 256, BK = 64, HALF = 128, HTB = HALF * BK * 2  , STAGE_BYTES = 8 * HTB, NXCD = 8, WGM = 8;

__host__ __device__ __forceinline__ int lds_byte(int r, int c) { const int st = (r >> 4) * 2 + (c >> 5), rr = r & 15, cc = c & 31, ob = rr * 64 + cc * 2; return st * 1024 + (ob ^ (((ob >> 9) & 1) << 5)); }
__host__ __device__ __forceinline__ void stage_rc(int b, int& R, int& C) { const int st = b / 1024, sb = b % 1024, swz = sb ^ (((sb >> 9) & 1) << 5); R = (st >> 1) * 16 + swz / 64; C = (st & 1) * 32 + (swz % 64) / 2; }
__host__ __device__ __forceinline__ int perm32(int rho) { const int n = rho >> 4, i = rho & 15; return 8 * (i >> 2) + 4 * n + (i & 3); }

struct Unit { int pm, pn; };
struct Gemm { const bf16_t* A; const bf16_t* Bt; int M, N, K; };

struct StaticOrder {
    int nM, nN, nwg, G, c;
    __host__ __device__ void init(int M, int N, int G_, int c_) { nM = M / BM; nN = N / BM; nwg = nM * nN; G = G_; c = c_; }
    __host__ __device__ bool next(int i, Unit& u) const {
        const long L = (long)i * G + c; if (L >= nwg) return false;
        int wgid = (int)L; { const int q = nwg / NXCD, r = nwg % NXCD, xcd = wgid % NXCD, off = wgid / NXCD; wgid = (xcd < r ? xcd * (q + 1) : r * (q + 1) + (xcd - r) * q) + off; }
        const int nig = WGM * nN, gid = wgid / nig, fm = gid * WGM, gsz = (nM - fm) < WGM ? (nM - fm) : WGM;
        u.pm = fm + ((wgid % nig) % gsz); u.pn = (wgid % nig) / gsz; return true;
    }
    __device__ __forceinline__ void a_ready(const Unit&) const {}
    __device__ __forceinline__ void done(const Unit&) const {}
};

__device__ __forceinline__ unsigned cvt_pk_bf16(float lo, float hi) { unsigned r; asm volatile("v_cvt_pk_bf16_f32 %0, %1, %2" : "=v"(r) : "v"(lo), "v"(hi)); return r; }
typedef float f32x2 __attribute__((ext_vector_type(2)));
template <class Epi, class Sched, bool ALIGN_EPI = false, bool SP2 = false>
__device__ __forceinline__ void gemm_phase(PG8_LAS unsigned char* lds, const Gemm g, const Sched& S, const Epi& E, const int tid_in) {
    const int tid = tid_in, wid = __builtin_amdgcn_readfirstlane(tid >> 6), lane = tid & 63, wr = wid >> 2, wc = wid & 3, fr = lane & 15, fq = lane >> 4;
    const int K = g.K, nt = K / BK;
    unsigned voffA[2], voffB[2];
#pragma unroll
    for (int i = 0; i < 2; ++i) { int R, C; stage_rc(tid * 16 + i * 8192, R, C); const int Rb = Epi::PERM ? ((R & ~31) + perm32(R & 31)) : R;
        voffA[i] = (unsigned)(R * K + C) * 2u; voffB[i] = (unsigned)(Rb * K + C) * 2u; }
    const size_t kstep = (size_t)(BK * 2);
    const size_t hstep = (size_t)HALF * K * 2;
    const size_t tstep = 2 * hstep;
    const unsigned ldsw = (unsigned)wid * 1024u;
    const int aoff = lds_byte(wr * 64 + fr, fq * 8), boff = lds_byte(wc * 32 + fr, fq * 8);
#define PG8_SA(b, h) (((b) * 2 + (h)) * HTB)
#define PG8_SB(b, h) ((4 + (b) * 2 + (h)) * HTB)
#define PG8_STAGE(bufoff, gbase, voff) do { _Pragma("unroll") for (int _i = 0; _i < 2; ++_i) \
        __builtin_amdgcn_global_load_lds((const unsigned*)((const char*)(gbase) + (voff)[_i]), (PG8_LAS unsigned*)(lds + (bufoff) + ldsw + _i * 8192), 16, 0, 0); } while (0)
#define PG8_LDA(dst, b, h) do { _Pragma("unroll") for (int m = 0; m < 4; ++m) _Pragma("unroll") for (int k = 0; k < 2; ++k) dst[m][k] = *(const PG8_LAS bf16x8*)(lds + PG8_SA(b, h) + aoff + m * 2048 + k * 1024); } while (0)
#define PG8_LDB(dst, b, h) do { _Pragma("unroll") for (int n = 0; n < 2; ++n) _Pragma("unroll") for (int k = 0; k < 2; ++k) dst[n][k] = *(const PG8_LAS bf16x8*)(lds + PG8_SB(b, h) + boff + n * 2048 + k * 1024); } while (0)
#define PG8_MMA(ai, bj, At, Bt) do { __builtin_amdgcn_s_setprio(1); _Pragma("unroll") for (int m = 0; m < 4; ++m) _Pragma("unroll") for (int n = 0; n < 2; ++n) _Pragma("unroll") for (int k = 0; k < 2; ++k) \
        acc[ai][bj][m][n] = __builtin_amdgcn_mfma_f32_16x16x32_bf16(Bt[n][k], At[m][k], acc[ai][bj][m][n], 0, 0, 0); __builtin_amdgcn_s_setprio(0); } while (0)
#define PG8_WAIT_V(n) asm volatile("s_waitcnt vmcnt(" #n ")" ::: "memory")
#define PG8_WAIT_L(n) asm volatile("s_waitcnt lgkmcnt(" #n ")" ::: "memory")
#define PG8_BAR __builtin_amdgcn_s_barrier()
#define PG8_SCHED __builtin_amdgcn_sched_barrier(0)
    Unit cur, nxt; int ui = 0;
    if (!S.next(0, cur)) return;
    f32x4 acc[2][2][4][2];
#pragma unroll
    for (int a = 0; a < 2; ++a)
#pragma unroll
        for (int b = 0; b < 2; ++b)
#pragma unroll
            for (int m = 0; m < 4; ++m)
#pragma unroll
                for (int n = 0; n < 2; ++n) acc[a][b][m][n] = (f32x4){0.f, 0.f, 0.f, 0.f};
    bf16x8 At[4][2], B0[2][2], B1[2][2];
    const char* cA = (const char*)g.A + (size_t)cur.pm * tstep; const char* cB = (const char*)g.Bt + (size_t)cur.pn * tstep;
    S.a_ready(cur);
    if constexpr (SP2) {
        PG8_STAGE(PG8_SB(0, 0), cB, voffB); PG8_STAGE(PG8_SB(0, 1), cB + hstep, voffB); PG8_STAGE(PG8_SA(0, 0), cA, voffA); PG8_STAGE(PG8_SA(0, 1), cA + hstep, voffA);
        if (wr == 1) PG8_BAR;
        PG8_WAIT_V(2); PG8_BAR;
        PG8_STAGE(PG8_SB(1, 0), cB + kstep, voffB); PG8_STAGE(PG8_SA(1, 0), cA + kstep, voffA); PG8_STAGE(PG8_SB(1, 1), cB + hstep + kstep, voffB);
        PG8_WAIT_V(6); PG8_BAR;
    } else {
        PG8_STAGE(PG8_SB(0, 0), cB, voffB); PG8_STAGE(PG8_SA(0, 0), cA, voffA); PG8_STAGE(PG8_SB(0, 1), cB + hstep, voffB); PG8_STAGE(PG8_SA(0, 1), cA + hstep, voffA);
        if (wr == 1) PG8_BAR;
        PG8_WAIT_V(4); PG8_BAR;
        PG8_STAGE(PG8_SB(1, 0), cB + kstep, voffB); PG8_STAGE(PG8_SA(1, 0), cA + kstep, voffA); PG8_STAGE(PG8_SB(1, 1), cB + hstep + kstep, voffB);
        PG8_WAIT_V(6); PG8_BAR;
    }
    for (;;) {
        const bool has_next = S.next(ui + 1, nxt);
        const char* nA = has_next ? (const char*)g.A + (size_t)nxt.pm * tstep : cA; const char* nB = has_next ? (const char*)g.Bt + (size_t)nxt.pn * tstep : cB;
        for (int t = 0; t < nt; t += 2) {
            const bool last = (t == nt - 2);
            const char* a1 = cA + (size_t)(t + 1) * kstep;
            const char* a2 = last ? nA : cA + (size_t)(t + 2) * kstep; const char* b2 = last ? nB : cB + (size_t)(t + 2) * kstep;
            const char* a3 = a2 + kstep; const char* b3 = b2 + kstep;
            if (last && has_next) S.a_ready(nxt);
            if constexpr (SP2) {
            PG8_LDB(B0, 0, 0); PG8_LDB(B1, 0, 1); PG8_SCHED; PG8_LDA(At, 0, 0); PG8_STAGE(PG8_SA(1, 1), a1 + hstep, voffA);
            PG8_WAIT_V(8); PG8_WAIT_L(0); PG8_BAR; PG8_MMA(0, 0, At, B0); PG8_MMA(0, 1, At, B1); PG8_BAR; PG8_SCHED;
            PG8_LDA(At, 0, 1); PG8_STAGE(PG8_SB(0, 0), b2, voffB); PG8_STAGE(PG8_SB(0, 1), b2 + hstep, voffB); PG8_STAGE(PG8_SA(0, 0), a2, voffA);
            PG8_WAIT_V(8); PG8_WAIT_L(0); PG8_BAR; PG8_MMA(1, 0, At, B0); PG8_MMA(1, 1, At, B1); PG8_BAR; PG8_SCHED;
            PG8_LDB(B0, 1, 0); PG8_LDB(B1, 1, 1); PG8_SCHED; PG8_LDA(At, 1, 0); PG8_STAGE(PG8_SA(0, 1), a2 + hstep, voffA);
            PG8_WAIT_V(8); PG8_WAIT_L(0); PG8_BAR; PG8_MMA(0, 0, At, B0); PG8_MMA(0, 1, At, B1); PG8_BAR; PG8_SCHED;
            PG8_LDA(At, 1, 1); PG8_STAGE(PG8_SB(1, 0), b3, voffB); PG8_STAGE(PG8_SB(1, 1), b3 + hstep, voffB); PG8_STAGE(PG8_SA(1, 0), a3, voffA);
            PG8_WAIT_V(8); PG8_WAIT_L(0); PG8_BAR; PG8_MMA(1, 0, At, B0); PG8_MMA(1, 1, At, B1); PG8_BAR; PG8_SCHED;
            } else {
            PG8_LDB(B0, 0, 0); PG8_SCHED; PG8_LDA(At, 0, 0); PG8_STAGE(PG8_SA(1, 1), a1 + hstep, voffA);
            PG8_WAIT_L(8); PG8_BAR; PG8_WAIT_L(0); PG8_MMA(0, 0, At, B0); PG8_BAR; PG8_SCHED;
            PG8_LDB(B1, 0, 1); PG8_STAGE(PG8_SB(0, 0), b2, voffB);
            PG8_BAR; PG8_WAIT_L(0); PG8_MMA(0, 1, At, B1); PG8_BAR;
            PG8_LDA(At, 0, 1); PG8_STAGE(PG8_SA(0, 0), a2, voffA);
            PG8_BAR; PG8_WAIT_L(0); PG8_MMA(1, 0, At, B0); PG8_BAR; PG8_SCHED;
            PG8_STAGE(PG8_SB(0, 1), b2 + hstep, voffB);
            PG8_WAIT_V(6); PG8_BAR; PG8_MMA(1, 1, At, B1); PG8_BAR;
            PG8_LDB(B0, 1, 0); PG8_SCHED; PG8_LDA(At, 1, 0); PG8_STAGE(PG8_SA(0, 1), a2 + hstep, voffA);
            PG8_WAIT_L(8); PG8_BAR; PG8_WAIT_L(0); PG8_MMA(0, 0, At, B0); PG8_BAR; PG8_SCHED;
            PG8_LDB(B1, 1, 1); PG8_STAGE(PG8_SB(1, 0), b3, voffB);
            PG8_BAR; PG8_WAIT_L(0); PG8_MMA(0, 1, At, B1); PG8_BAR;
            PG8_LDA(At, 1, 1); PG8_STAGE(PG8_SA(1, 0), a3, voffA);
            PG8_BAR; PG8_WAIT_L(0); PG8_MMA(1, 0, At, B0); PG8_BAR; PG8_SCHED;
            PG8_STAGE(PG8_SB(1, 1), b3 + hstep, voffB);
            PG8_WAIT_V(6); PG8_BAR; PG8_MMA(1, 1, At, B1); PG8_BAR;
            }
        }
        if constexpr (ALIGN_EPI) { if (wr == 0) PG8_BAR; }
        if constexpr (!Epi::AFTER_DRAIN) { E(acc, cur, wr, wc, fr, fq); S.done(cur); }
        if (!has_next) break;
#pragma unroll
        for (int a = 0; a < 2; ++a)
#pragma unroll
            for (int b = 0; b < 2; ++b)
#pragma unroll
                for (int m = 0; m < 4; ++m)
#pragma unroll
                    for (int n = 0; n < 2; ++n) acc[a][b][m][n] = (f32x4){0.f, 0.f, 0.f, 0.f};
        cur = nxt; cA = nA; cB = nB; ++ui;
        if constexpr (ALIGN_EPI) { if (wr == 1) PG8_BAR; }
    }
    PG8_WAIT_V(0);
    if constexpr (!ALIGN_EPI) { if (wr == 0) PG8_BAR; }
    PG8_BAR;
    if constexpr (Epi::AFTER_DRAIN) { E.fused(acc, cur, wr, wc, fr, fq, lds, wid, lane); S.done(cur); }
#undef PG8_SA
#undef PG8_SB
#undef PG8_STAGE
#undef PG8_LDA
#undef PG8_LDB
#undef PG8_MMA
#undef PG8_WAIT_V
#undef PG8_WAIT_L
#undef PG8_BAR
#undef PG8_SCHED
}
}
#define DI __device__ __forceinline__
#define LAS __attribute__((address_space(3)))
typedef unsigned short bf16_t;
typedef short bf16x8 __attribute__((ext_vector_type(8)));
typedef short s16x4 __attribute__((ext_vector_type(4)));
typedef float f32x4 __attribute__((ext_vector_type(4)));
typedef float f32x16 __attribute__((ext_vector_type(16)));
typedef unsigned u32x4 __attribute__((ext_vector_type(4)));
typedef unsigned u32x2 __attribute__((ext_vector_type(2)));
typedef float f32x2_t __attribute__((ext_vector_type(2)));
typedef __bf16 bf16x2_t __attribute__((ext_vector_type(2)));
typedef LAS unsigned char ldsb;

constexpr int DM = 2048, NB = 8, SEQ = 2048, MTOK = NB * SEQ;
constexpr int IN_COLS = 5656, NPAD = 5888;
constexpr int C_RQ = 0, C_RK = 512, C_RV = 1024, C_RG = 2048, C_NQ = 3072, C_KV = 4096, C_GATE = 5632;
constexpr float EPS = 1e-6f;
constexpr int NTHREADS = 512, NWAVES = 8;

constexpr size_t MiB = 1u << 20;
constexpr size_t WS_CTL = 0, CTL_BYTES = 1 * MiB;
constexpr size_t CTL_SSQ = 256 * 1024;
constexpr size_t WS_CBP = 486 * MiB;
constexpr size_t WS_WIN = 1 * MiB;
constexpr size_t WS_WOUT = 24 * MiB;
constexpr size_t WS_WQ = 32 * MiB;
constexpr size_t WS_TAB = 40 * MiB;
constexpr size_t TAB_COS = 0, TAB_SIN = 256 * 1024, TAB_LUT = 512 * 1024, TAB_RS1 = 576 * 1024, TAB_SK = 640 * 1024, TAB_W2T = 704 * 1024, TAB_UINV = 832 * 1024, TAB_VINV = 896 * 1024;
constexpr size_t WS_W1T = 41 * MiB;
constexpr size_t WS_KCMP = 45 * MiB;
constexpr size_t WS_VCMP = 45 * MiB + 512 * 1024;
constexpr size_t WS_XB = 46 * MiB;
constexpr size_t WS_PROJ = 110 * MiB;
constexpr size_t WS_MIX = 294 * MiB;
constexpr size_t WS_UB = 358 * MiB;
constexpr size_t WS_VB = 422 * MiB;
constexpr size_t WS_CPART0 = 406 * MiB, WS_CPART1 = 470 * MiB;
constexpr size_t WS_NSCR0 = 374 * MiB, WS_NSCR1 = 438 * MiB;
constexpr size_t WS_KVT = 488 * MiB;
constexpr size_t WS_END = 505 * MiB;

constexpr int LDS_BYTES = 147456 + 64;
constexpr int L_K = 0, L_V = 16384, L_WSF = 32768, L_LUT = 36864, L_MISC = 40960, L_Q = 49152, L_K2 = 114688, L_V2 = 131072;
constexpr int L_HID = 0;
constexpr int L_EL = 0, L_GL = 16384, L_UL = 32768, L_IDX = 49152, L_G2 = 57344, L_GF = 65536, L_SK = 73728;

DI unsigned f2bf(float f) { unsigned u = __builtin_bit_cast(unsigned, f); return (u + 0x7fffu + ((u >> 16) & 1u)) >> 16; }
DI unsigned pk2(float lo, float hi) { return f2bf(lo) | (f2bf(hi) << 16); }
DI unsigned cvtpk(float lo, float hi) { f32x2_t v = {lo, hi}; bf16x2_t b = __builtin_convertvector(v, bf16x2_t); return __builtin_bit_cast(unsigned, b); }
DI float dot2bf(unsigned a, unsigned b, float c) { return __builtin_amdgcn_fdot2_f32_bf16(__builtin_bit_cast(bf16x2_t, a), __builtin_bit_cast(bf16x2_t, b), c, false); }
DI float bflo(unsigned u) { return __builtin_bit_cast(float, u << 16); }
DI float bfhi(unsigned u) { return __builtin_bit_cast(float, u & 0xffff0000u); }
DI float bf2f(bf16_t h) { return __builtin_bit_cast(float, (unsigned)h << 16); }
DI float wave_sum(float v) {
#pragma unroll
    for (int o = 1; o < 64; o <<= 1) v += __shfl_xor(v, o);
    return v;
}
template <int CTRL, int ROWMASK> DI float dpp_add(float v) {
    const int t = __builtin_amdgcn_update_dpp(0, __builtin_bit_cast(int, v), CTRL, ROWMASK, 0xf, true);
    return v + __builtin_bit_cast(float, t);
}
DI float wave_sum_u(float v) {
    v = dpp_add<0x111, 0xf>(v);
    v = dpp_add<0x112, 0xf>(v);
    v = dpp_add<0x114, 0xf>(v);
    v = dpp_add<0x118, 0xf>(v);
    v = dpp_add<0x142, 0xa>(v);
    v = dpp_add<0x143, 0xc>(v);
    return __builtin_bit_cast(float, __builtin_amdgcn_readlane(__builtin_bit_cast(int, v), 63));
}
DI float half_sum(float v) {
#pragma unroll
    for (int o = 1; o < 32; o <<= 1) v += __shfl_xor(v, o);
    return v;
}
typedef __amdgpu_buffer_rsrc_t rsrc_t;
DI rsrc_t mk_rsrc(const void* p, unsigned bytes) { return __builtin_amdgcn_make_buffer_rsrc((void*)p, (short)0, (int)bytes, 0x00020000); }
DI u32x4 bld128(rsrc_t r, unsigned voff, unsigned soff) { return __builtin_amdgcn_raw_buffer_load_b128(r, (int)voff, (int)soff, 0); }
DI f32x4 bldf4(rsrc_t r, unsigned voff, unsigned soff) { return __builtin_bit_cast(f32x4, __builtin_amdgcn_raw_buffer_load_b128(r, (int)voff, (int)soff, 0)); }
DI void bstf4(rsrc_t r, unsigned voff, unsigned soff, f32x4 v) { __builtin_amdgcn_raw_buffer_store_b128(__builtin_bit_cast(u32x4, v), r, (int)voff, (int)soff, 0); }
DI int crow(int r, int hi) { return (r & 3) + 8 * (r >> 2) + 4 * hi; }
DI unsigned offb(unsigned row, unsigned ch) { return 256u * row + 16u * (ch ^ (((row & 3u) << 2) | ((row >> 2) & 3u))); }
DI unsigned offk64(unsigned row, unsigned ch) { return 128u * row + 16u * (ch ^ (row & 7u)); }
#define MFMA32(a, b, c) __builtin_amdgcn_mfma_f32_32x32x16_bf16((a), (b), (c), 0, 0, 0)
DI bf16x8 packf(const f32x16& x, int s) {
    u32x4 p = {cvtpk(x[8 * s], x[8 * s + 1]), cvtpk(x[8 * s + 2], x[8 * s + 3]), cvtpk(x[8 * s + 4], x[8 * s + 5]), cvtpk(x[8 * s + 6], x[8 * s + 7])};
    return __builtin_bit_cast(bf16x8, p);
}
DI float gelu_tanh(float x) {
    const float z = 0.7978845608028654f * (x + 0.044715f * x * x * x);
    const float e = __expf(2.f * z);
    const float th = 1.f - 2.f * __builtin_amdgcn_rcpf(e + 1.f);
    return 0.5f * x * (1.f + th);
}
typedef short v4i16_t __attribute__((ext_vector_type(4)));
DI s16x4 vtr(ldsb* p) { return __builtin_bit_cast(s16x4, __builtin_amdgcn_ds_read_tr16_b64_v4i16((LAS v4i16_t*)p)); }

DI void qk128(f32x16& p0, f32x16& p1, ldsb* Kl, const bf16x8 (&qf)[8], int r32, int hi) {
#pragma unroll
    for (int s = 0; s < 8; ++s) {
        const bf16x8 a0 = *(LAS bf16x8*)(Kl + offb(r32, 2 * s + hi));
        const bf16x8 a1 = *(LAS bf16x8*)(Kl + offb(32 + r32, 2 * s + hi));
        p0 = MFMA32(a0, qf[s], p0); p1 = MFMA32(a1, qf[s], p1);
    }
}
DI void qk128l(f32x16& p0, f32x16& p1, ldsb* Kl, ldsb* Ql, int lane, int r32, int hi) {
#pragma unroll
    for (int s = 0; s < 8; ++s) {
        const bf16x8 qv = *(LAS bf16x8*)(Ql + (s * 64 + lane) * 16);
        const bf16x8 a0 = *(LAS bf16x8*)(Kl + offb(r32, 2 * s + hi));
        const bf16x8 a1 = *(LAS bf16x8*)(Kl + offb(32 + r32, 2 * s + hi));
        p0 = MFMA32(a0, qv, p0); p1 = MFMA32(a1, qv, p1);
    }
}
DI void qk64(f32x16& p0, f32x16& p1, ldsb* Kl, const bf16x8 (&qf)[4], int r32, int hi) {
#pragma unroll
    for (int s = 0; s < 4; ++s) {
        const bf16x8 a0 = *(LAS bf16x8*)(Kl + offk64(r32, 2 * s + hi));
        const bf16x8 a1 = *(LAS bf16x8*)(Kl + offk64(32 + r32, 2 * s + hi));
        p0 = MFMA32(a0, qf[s], p0); p1 = MFMA32(a1, qf[s], p1);
    }
}
DI void pv128(f32x16 (&o)[4], const f32x16& p0, const f32x16& p1, ldsb* Vl, int lane) {
    const bf16x8 pa[4] = {packf(p0, 0), packf(p0, 1), packf(p1, 0), packf(p1, 1)};
    const unsigned h = lane >> 5, blk = (lane >> 4) & 1, q = (lane & 15) >> 2, p = lane & 3;
#pragma unroll
    for (int c = 0; c < 4; ++c)
#pragma unroll
        for (int s = 0; s < 4; ++s) {
            const unsigned ch = 4 * c + 2 * blk + (p >> 1);
            const s16x4 lo = vtr(Vl + offb(16 * s + 4 * h + q, ch) + 8 * (p & 1));
            const s16x4 hi_ = vtr(Vl + offb(16 * s + 8 + 4 * h + q, ch) + 8 * (p & 1));
            const bf16x8 bfrag = {lo[0], lo[1], lo[2], lo[3], hi_[0], hi_[1], hi_[2], hi_[3]};
            o[c] = MFMA32(pa[s], bfrag, o[c]);
            if (s == 3) __builtin_amdgcn_sched_barrier(0);
        }
}
DI void stage128(ldsb* dst, const bf16_t* src, size_t pitch, int tid) {
    const int row = tid >> 4, ch = tid & 15;
    const u32x4 v0 = *(const u32x4*)(src + (size_t)row * pitch + 8 * ch), v1 = *(const u32x4*)(src + (size_t)(row + 32) * pitch + 8 * ch);
    *(LAS u32x4*)(dst + offb(row, ch)) = v0; *(LAS u32x4*)(dst + offb(row + 32, ch)) = v1;
}
DI void stage128x2(ldsb* dk, const bf16_t* sk, ldsb* dv, const bf16_t* sv, size_t pitch, int tid) {
    const int row = tid >> 4, ch = tid & 15;
    const u32x4 k0 = *(const u32x4*)(sk + (size_t)row * pitch + 8 * ch), k1 = *(const u32x4*)(sk + (size_t)(row + 32) * pitch + 8 * ch);
    const u32x4 v0 = *(const u32x4*)(sv + (size_t)row * pitch + 8 * ch), v1 = *(const u32x4*)(sv + (size_t)(row + 32) * pitch + 8 * ch);
    *(LAS u32x4*)(dk + offb(row, ch)) = k0; *(LAS u32x4*)(dk + offb(row + 32, ch)) = k1;
    *(LAS u32x4*)(dv + offb(row, ch)) = v0; *(LAS u32x4*)(dv + offb(row + 32, ch)) = v1;
}

DI void p0_transpose_item(const float* W, int K, int N, bf16_t* WT, LAS float* scr, int item, int nblk, int lane, const float* kscale, int csmode) {
    const int kb = item / nblk, nb = item % nblk, k0 = 64 * kb, n0 = 32 * nb;
    const int n = n0 + (lane & 31);
    float cs = 1.f;
    int nsrc = n;
    if (csmode == 1) {
        if (n < 512) cs = 0.125f; else if (n >= C_NQ && n < C_KV) cs = 0.08838834764831845f * 1.4426950408889634f;
        if (n < 1024) { const int p = n & 63; nsrc = (n & ~63) + (p >> 1) + 32 * (p & 1); }
    }
    float wv[32];
    const float* wp = W + (size_t)(k0 + (lane >> 5)) * N + ((n < N) ? nsrc : 0);
#pragma unroll
    for (int i = 0; i < 32; ++i) wv[i] = wp[(size_t)(2 * i) * N];
    float ksv[32];
    if (kscale) {
#pragma unroll
        for (int i = 0; i < 32; ++i) ksv[i] = kscale[k0 + 2 * i + (lane >> 5)];
    } else {
#pragma unroll
        for (int i = 0; i < 32; ++i) ksv[i] = 1.f;
    }
    if (n >= N) cs = 0.f;
#pragma unroll
    for (int i = 0; i < 32; ++i) {
        const int kk = 2 * i + (lane >> 5);
        scr[kk * 33 + (lane & 31)] = wv[i] * ksv[i] * cs;
    }
    asm volatile("s_waitcnt lgkmcnt(0)" ::: "memory");
    const int c = lane & 7;
#pragma unroll
    for (int j = 0; j < 4; ++j) {
        const int nn = (lane >> 3) + 8 * j; const LAS float* s = scr + (8 * c) * 33 + nn;
        u32x4 o; o.x = pk2(s[0 * 33], s[1 * 33]); o.y = pk2(s[2 * 33], s[3 * 33]); o.z = pk2(s[4 * 33], s[5 * 33]); o.w = pk2(s[6 * 33], s[7 * 33]);
        *(u32x4*)(WT + (size_t)(n0 + nn) * K + k0 + 8 * c) = o;
    }
    asm volatile("s_waitcnt lgkmcnt(0)" ::: "memory");
}
DI void row_to_bf16(const f32x4 (&v)[8], bf16_t* orow, float* rs_out, int lane) {
    float s = 0.f;
#pragma unroll
    for (int j = 0; j < 8; ++j) s += (v[j].x * v[j].x + v[j].y * v[j].y) + (v[j].z * v[j].z + v[j].w * v[j].w);
    if (rs_out) { s = wave_sum(s); if (lane == 0) *rs_out = rsqrtf(s * (1.f / DM) + EPS); }
    u32x2* o8 = (u32x2*)orow + lane;
#pragma unroll
    for (int j = 0; j < 8; ++j) { u32x2 w; w.x = pk2(v[j].x, v[j].y); w.y = pk2(v[j].z, v[j].w); o8[64 * j] = w; }
}
DI void row_to_fp4(const f32x4 (&v)[8], unsigned char* orow, float* inv_out, int lane) {
    float am = 0.f;
#pragma unroll
    for (int j = 0; j < 8; ++j) am = fmaxf(fmaxf(am, fmaxf(fabsf(v[j].x), fabsf(v[j].y))), fmaxf(fabsf(v[j].z), fabsf(v[j].w)));
#pragma unroll
    for (int o = 1; o < 64; o <<= 1) am = fmaxf(am, __shfl_xor(am, o));
    const float sc = am > 0.f ? 6.f / am : 1.f;
    if (lane == 0) *inv_out = am > 0.f ? am * (1.f / 6.f) : 1.f;
    unsigned* o4 = (unsigned*)orow + lane;
#pragma unroll
    for (int j = 0; j < 4; ++j) {
        unsigned w = 0u;
        w = __builtin_amdgcn_cvt_scalef32_pk_fp4_f32(w, v[2 * j].x * sc, v[2 * j].y * sc, 1.0f, 0);
        w = __builtin_amdgcn_cvt_scalef32_pk_fp4_f32(w, v[2 * j].z * sc, v[2 * j].w * sc, 1.0f, 1);
        w = __builtin_amdgcn_cvt_scalef32_pk_fp4_f32(w, v[2 * j + 1].x * sc, v[2 * j + 1].y * sc, 1.0f, 2);
        w = __builtin_amdgcn_cvt_scalef32_pk_fp4_f32(w, v[2 * j + 1].z * sc, v[2 * j + 1].w * sc, 1.0f, 3);
        o4[64 * j] = w;
    }
}
DI int t5_bucket(int d) {
    if (d < 16) return d;
    const float lr = logf((float)d / 16.f) / 2.0794415416798357f;
    int v = 16 + (int)(lr * 16.f);
    return v < 31 ? v : 31;
}
struct Ptrs {
    const float *x, *norm1_g, *w_in, *rel_bias, *ret_gn_g, *cmp_pe, *cmp_w1, *cmp_w2, *nsa_out_g, *w_out, *norm2_g, *peer_wq, *peer_sk, *peer_u, *peer_v, *norm_f_g;
    float* out; unsigned char* ws;
};
DI void row_issue(const Ptrs& P, int m, f32x4 (&v)[8], int lane) {
    if (m < MTOK) {
        const f32x4* xr = (const f32x4*)(P.x + (size_t)m * DM) + lane;
#pragma unroll
        for (int j = 0; j < 8; ++j) v[j] = xr[64 * j];
    } else {
        const f32x4* xr = (const f32x4*)((m < 2 * MTOK) ? P.peer_u + (size_t)(m - MTOK) * DM : P.peer_v + (size_t)(m - 2 * MTOK) * DM);
#pragma unroll
        for (int j = 0; j < 4; ++j) { v[2 * j] = xr[2 * (lane + 64 * j)]; v[2 * j + 1] = xr[2 * (lane + 64 * j) + 1]; }
    }
}
DI void phase0(const Ptrs& P, ldsb* lds, int tid, int G) {
    const int lane = tid & 63, wid = __builtin_amdgcn_readfirstlane(tid >> 6);
    LAS float* scr = (LAS float*)(lds + wid * 16384);
    const int gw = blockIdx.x * NWAVES + wid, NGW = G * NWAVES;
    unsigned char* ws = P.ws;
    constexpr int I1 = 32 * 184, I2 = 32 * 64, I3 = 32 * 64, I4 = 2 * 64 * 8, I5 = 2 * 4 * 4;
    constexpr int NT = I1 + I2 + I3 + I4 + I5;
    for (int it = gw; it < NT; it += NGW) {
        int r = it;
        if (r < I1) { p0_transpose_item(P.w_in, DM, IN_COLS, (bf16_t*)(ws + WS_WIN), scr, r, 184, lane, P.norm1_g, 1); continue; } r -= I1;
        if (r < I2) { p0_transpose_item(P.w_out, DM, DM, (bf16_t*)(ws + WS_WOUT), scr, r, 64, lane, nullptr, 0); continue; } r -= I2;
        if (r < I3) { p0_transpose_item(P.peer_wq, DM, DM, (bf16_t*)(ws + WS_WQ), scr, r, 64, lane, P.norm2_g, 0); continue; } r -= I3;
        if (r < I4) { const int kv = r / 512; p0_transpose_item(P.cmp_w1 + (size_t)kv * 4096 * 256, 4096, 256, (bf16_t*)(ws + WS_W1T) + (size_t)kv * 256 * 4096, scr, r % 512, 8, lane, nullptr, 0); continue; } r -= I4;
        { const int kv = r / 16; p0_transpose_item(P.cmp_w2 + (size_t)kv * 256 * 128, 256, 128, (bf16_t*)(ws + WS_TAB + TAB_W2T) + (size_t)kv * 128 * 256, scr, r % 16, 4, lane, nullptr, 0); }
    }
    for (int it = gw; it < 512; it += NGW) {
        const int kv = it >> 8, nb = (it >> 6) & 3, kc = it & 63, n = nb * 64 + lane;
        const float* w1 = P.cmp_w1 + (size_t)kv * 4096 * 256; const float* pe = P.cmp_pe + (size_t)kv * 4096;
        float a = 0.f;
#pragma unroll
        for (int k0 = 0; k0 < 64; k0 += 32) {
            float wv[32];
#pragma unroll
            for (int k = 0; k < 32; ++k) wv[k] = w1[(size_t)(kc * 64 + k0 + k) * 256 + n];
#pragma unroll
            for (int k = 0; k < 32; ++k) a += pe[kc * 64 + k0 + k] * wv[k];
        }
        ((float*)(ws + WS_CBP))[(kv * 64 + kc) * 256 + n] = a;
    }
    {
        const int mend = (G == 256) ? MTOK : 3 * MTOK;
        f32x4 cur[8], nxt[8];
        if (gw < mend) row_issue(P, gw, cur, lane);
        for (int m = gw; m < mend; m += NGW) {
            const int mn = m + NGW;
            if (mn < mend) row_issue(P, mn, nxt, lane);
            if (m < MTOK) row_to_bf16(cur, (bf16_t*)(ws + WS_XB) + (size_t)m * DM, (float*)(ws + WS_TAB + TAB_RS1) + m, lane);
            else if (m < 2 * MTOK) { const int e = m - MTOK; row_to_fp4(cur, ws + WS_UB + (size_t)e * (DM / 2), (float*)(ws + WS_TAB + TAB_UINV) + e, lane); }
            else { const int e = m - 2 * MTOK; row_to_fp4(cur, ws + WS_VB + (size_t)e * (DM / 2), (float*)(ws + WS_TAB + TAB_VINV) + e, lane); }
#pragma unroll
            for (int j = 0; j < 8; ++j) cur[j] = nxt[j];
        }
    }
    const int gt = blockIdx.x * NTHREADS + tid, NGT = G * NTHREADS;
    float* ct = (float*)(ws + WS_TAB + TAB_COS); float* st = (float*)(ws + WS_TAB + TAB_SIN);
    for (int i = gt; i < SEQ * 32; i += NGT) {
        const int pos = i >> 5, k = i & 31;
        const float inv = 1.0f / powf(10000.0f, (float)k / 32.0f);
        const float ang = (float)pos * inv;
        ct[i] = cosf(ang); st[i] = sinf(ang);
    }
    float* lut = (float*)(ws + WS_TAB + TAB_LUT);
    for (int i = gt; i < 128 * 8; i += NGT) { const int d = i >> 3, hh = i & 7; lut[i] = P.rel_bias[t5_bucket(d) * 8 + hh]; }
    bf16_t* skb = (bf16_t*)(ws + WS_TAB + TAB_SK);
    for (int i = gt; i < 2 * 128 * 128; i += NGT) skb[i] = (bf16_t)f2bf(P.peer_sk[i]);
}
namespace pg8 {
struct EpiRowScaleBf16 {
    static constexpr bool PERM = true, AFTER_DRAIN = false;
    bf16_t* O; int ldc; const float* rs; int mode;
    __device__ __forceinline__ void operator()(const f32x4 (&acc)[2][2][4][2], const Unit& u, int wr, int wc, int fr, int fq) const {
        const int row0 = u.pm * BM + wr * 64 + fr, col0 = u.pn * BM + wc * 32 + 8 * fq;
        float scv[2][4];
#pragma unroll
        for (int ai = 0; ai < 2; ++ai)
#pragma unroll
            for (int m = 0; m < 4; ++m) scv[ai][m] = rs[row0 + ai * HALF + m * 16];
        __builtin_amdgcn_sched_barrier(0);
#pragma unroll
        for (int ai = 0; ai < 2; ++ai)
#pragma unroll
            for (int m = 0; m < 4; ++m) {
                const int row = row0 + ai * HALF + m * 16;
                float sc = scv[ai][m]; if (mode == 1) sc = rsqrtf(sc * (1.f / 2048.f) + 1e-6f);
                bf16_t* rowp = O + (size_t)row * ldc + col0;
#pragma unroll
                for (int bj = 0; bj < 2; ++bj) {
                    const f32x4 v0 = acc[ai][bj][m][0] * sc, v1 = acc[ai][bj][m][1] * sc;
                    u32x4 w; w.x = cvt_pk_bf16(v0[0], v0[1]); w.y = cvt_pk_bf16(v0[2], v0[3]); w.z = cvt_pk_bf16(v1[0], v1[1]); w.w = cvt_pk_bf16(v1[2], v1[3]);
                    *(u32x4*)(rowp + bj * HALF) = w;
                }
            }
    }
};
struct EpiProj {
    static constexpr bool PERM = true, AFTER_DRAIN = false;
    bf16_t* O; int ldc; const float* rs; const float* ct; const float* st;
    __device__ __forceinline__ void operator()(const f32x4 (&acc)[2][2][4][2], const Unit& u, int wr, int wc, int fr, int fq) const {
        const int row0 = u.pm * BM + wr * 64 + fr, col0 = u.pn * BM + wc * 32 + 8 * fq;
        const bool rot = u.pn < 4;
        float scv[2][4];
#pragma unroll
        for (int ai = 0; ai < 2; ++ai)
#pragma unroll
            for (int m = 0; m < 4; ++m) scv[ai][m] = rs[row0 + ai * HALF + m * 16];
        __builtin_amdgcn_sched_barrier(0);
#pragma unroll
        for (int ai = 0; ai < 2; ++ai) {
            f32x4 cv[4][2], sv[4][2];
            if (rot) {
#pragma unroll
                for (int m = 0; m < 4; ++m)
#pragma unroll
                    for (int bj = 0; bj < 2; ++bj) {
                        const int t = (row0 + ai * HALF + m * 16) & 2047, i0 = ((col0 + bj * HALF) & 63) >> 1;
                        cv[m][bj] = *(const f32x4*)(ct + t * 32 + i0); sv[m][bj] = *(const f32x4*)(st + t * 32 + i0);
                    }
                __builtin_amdgcn_sched_barrier(0);
            }
#pragma unroll
            for (int m = 0; m < 4; ++m) {
                const int row = row0 + ai * HALF + m * 16; const int t = row & 2047;
                const float sc = scv[ai][m];
                bf16_t* rowp = O + (size_t)row * ldc + col0;
#pragma unroll
                for (int bj = 0; bj < 2; ++bj) {
                    f32x4 v0 = acc[ai][bj][m][0] * sc, v1 = acc[ai][bj][m][1] * sc;
                    if (rot) {
                        const int col = col0 + bj * HALF, h = (col >> 6) & 7;
                        const float l2g = __log2f(1.f - exp2f(-5.f - (float)h));
                        const float dsc = exp2f(l2g * (float)(col < 512 ? (t & 31) : 63 - (t & 63)));
                        const f32x4 c4 = cv[m][bj], s4 = sv[m][bj];
                        f32x4 y0, y1;
                        y0[0] = (v0[0] * c4[0] - v0[1] * s4[0]) * dsc; y0[1] = (v0[0] * s4[0] + v0[1] * c4[0]) * dsc;
                        y0[2] = (v0[2] * c4[1] - v0[3] * s4[1]) * dsc; y0[3] = (v0[2] * s4[1] + v0[3] * c4[1]) * dsc;
                        y1[0] = (v1[0] * c4[2] - v1[1] * s4[2]) * dsc; y1[1] = (v1[0] * s4[2] + v1[1] * c4[2]) * dsc;
                        y1[2] = (v1[2] * c4[3] - v1[3] * s4[3]) * dsc; y1[3] = (v1[2] * s4[3] + v1[3] * c4[3]) * dsc;
                        v0 = y0; v1 = y1;
                    }
                    u32x4 w; w.x = cvt_pk_bf16(v0[0], v0[1]); w.y = cvt_pk_bf16(v0[2], v0[3]); w.z = cvt_pk_bf16(v1[0], v1[1]); w.w = cvt_pk_bf16(v1[2], v1[3]);
                    *(u32x4*)(rowp + bj * HALF) = w;
                }
            }
        }
    }
};
struct EpiResidual {
    static constexpr bool PERM = false, AFTER_DRAIN = false;
    const bf16_t* X; float* H; bf16_t* HB; float* ssq; int ldc;
    __device__ __forceinline__ void operator()(const f32x4 (&acc)[2][2][4][2], const Unit& u, int wr, int wc, int fr, int fq) const {
        typedef unsigned u32x2v __attribute__((ext_vector_type(2)));
        const int row0 = u.pm * BM + wr * 64 + fr, col0 = u.pn * BM + wc * 32 + 4 * fq;
#pragma unroll
        for (int ai = 0; ai < 2; ++ai) {
            f32x4 xv[4][2][2];
#pragma unroll
            for (int m = 0; m < 4; ++m)
#pragma unroll
                for (int bj = 0; bj < 2; ++bj)
#pragma unroll
                    for (int n = 0; n < 2; ++n) {
                        const u32x2v xr = *(const u32x2v*)(X + (size_t)(row0 + ai * HALF + m * 16) * ldc + col0 + bj * HALF + n * 16);
                        xv[m][bj][n] = f32x4{__builtin_bit_cast(float, xr.x << 16), __builtin_bit_cast(float, xr.x & 0xffff0000u), __builtin_bit_cast(float, xr.y << 16), __builtin_bit_cast(float, xr.y & 0xffff0000u)};
                    }
            asm volatile("s_waitcnt vmcnt(0)" ::: "memory");
            __builtin_amdgcn_sched_barrier(0);
#pragma unroll
            for (int m = 0; m < 4; ++m) {
                const int row = row0 + ai * HALF + m * 16; float sq = 0.f;
#pragma unroll
                for (int bj = 0; bj < 2; ++bj)
#pragma unroll
                    for (int n = 0; n < 2; ++n) {
                        const size_t off = (size_t)row * ldc + col0 + bj * HALF + n * 16;
                        const f32x4 hv = xv[m][bj][n] + acc[ai][bj][m][n];
                        sq += (hv[0] * hv[0] + hv[1] * hv[1]) + (hv[2] * hv[2] + hv[3] * hv[3]);
                        u32x2v w; w.x = cvt_pk_bf16(hv[0], hv[1]); w.y = cvt_pk_bf16(hv[2], hv[3]);
                        *(u32x2v*)(HB + off) = w;
                    }
                sq += __shfl_xor(sq, 16); sq += __shfl_xor(sq, 32);
                if (fq == 0) unsafeAtomicAdd(ssq + row, sq);
            }
        }
    }
};
}

DI void load8bf(const bf16_t* p, float (&o)[8]) {
    const u32x4 v = *(const u32x4*)p;
    o[0] = bflo(v.x); o[1] = bfhi(v.x); o[2] = bflo(v.y); o[3] = bfhi(v.y); o[4] = bflo(v.z); o[5] = bfhi(v.z); o[6] = bflo(v.w); o[7] = bfhi(v.w);
}
DI void load8f(const float* p, float (&o)[8]) {
    const f32x4 a = *(const f32x4*)p, b = *(const f32x4*)(p + 4);
    o[0] = a[0]; o[1] = a[1]; o[2] = a[2]; o[3] = a[3]; o[4] = b[0]; o[5] = b[1]; o[6] = b[2]; o[7] = b[3];
}
DI u32x4 pack8(const float (&v)[8]) { u32x4 w = {cvtpk(v[0], v[1]), cvtpk(v[2], v[3]), cvtpk(v[4], v[5]), cvtpk(v[6], v[7])}; return w; }

DI void convert_table_rows(const Ptrs& P, int which, int first, int stride, int lane, int end = MTOK) {
    unsigned char* ws = P.ws;
    const int base = (which + 1) * MTOK;
    unsigned char* dst = ws + (which ? WS_VB : WS_UB); float* inv = (float*)(ws + WS_TAB + (which ? TAB_VINV : TAB_UINV));
    f32x4 cur[8], nxt[8];
    if (first < end) row_issue(P, base + first, cur, lane);
    for (int e = first; e < end; e += stride) {
        const int en = e + stride;
        if (en < end) row_issue(P, base + en, nxt, lane);
        row_to_fp4(cur, dst + (size_t)e * (DM / 2), inv + e, lane);
#pragma unroll
        for (int j = 0; j < 8; ++j) cur[j] = nxt[j];
    }
}
DI void retention_state_units(ldsb* lds, const Ptrs& P, int it0, int G, int tid) {
    const int lane = tid & 63, wid = __builtin_amdgcn_readfirstlane(tid >> 6), hi = lane >> 5;
    const bf16_t* proj = (const bf16_t*)(P.ws + WS_PROJ);
    ldsb* Kl = lds; ldsb* Vl = lds + 16384;
    u32x4 kq[2], vq[4];
#define RS_LOAD(IT) do { const int bh_ = (IT) & 63, b_ = bh_ >> 3, h_ = bh_ & 7, c_ = (IT) >> 6; const size_t row0_ = (size_t)b_ * SEQ + 128 * c_; \
        _Pragma("unroll") for (int i = 0; i < 2; ++i) { const int ci = tid + 512 * i, row = ci >> 3, ch = ci & 7; kq[i] = *(const u32x4*)(proj + (row0_ + row) * NPAD + C_RK + h_ * 64 + 8 * ch); } \
        _Pragma("unroll") for (int i = 0; i < 4; ++i) { const int ci = tid + 512 * i, row = ci >> 4, ch = ci & 15; vq[i] = *(const u32x4*)(proj + (row0_ + row) * NPAD + C_RV + h_ * 128 + 8 * ch); } } while (0)
    if (it0 < 1024) RS_LOAD(it0);
    for (int it = it0; it < 1024; it += G) {
        const int bh = it & 63, b = bh >> 3, h = bh & 7, c = it >> 6;
        bf16_t* kvt = (bf16_t*)(P.ws + WS_KVT) + ((size_t)((b * 8 + h) * 16 + c)) * 128 * 64;
        const float l2g = log2f(1.f - exp2f(-5.f - (float)h));
        __syncthreads();
#pragma unroll
        for (int i = 0; i < 2; ++i) { const int ci = tid + 512 * i, row = ci >> 3, ch = ci & 7; *(LAS u32x4*)(Kl + (row >> 6) * 8192 + offk64(row & 63, ch)) = kq[i]; }
#pragma unroll
        for (int i = 0; i < 4; ++i) { const int ci = tid + 512 * i, row = ci >> 4, ch = ci & 15; *(LAS u32x4*)(Vl + (row >> 6) * 16384 + offb(row & 63, ch)) = vq[i]; }
        if (it + G < 1024) RS_LOAD(it + G);
        __syncthreads();
        const int dkb = wid & 1, cb = wid >> 1;
        const unsigned hh2 = lane >> 5, blk = (lane >> 4) & 1, q = (lane & 15) >> 2, p = lane & 3;
        f32x16 acc;
#pragma unroll
        for (int r = 0; r < 16; ++r) acc[r] = 0.f;
#pragma unroll
        for (int tile = 0; tile < 2; ++tile) {
#pragma unroll
            for (int s4 = 0; s4 < 4; ++s4) {
                const unsigned r_lo = 16 * s4 + 4 * hh2 + q, r_hi = r_lo + 8;
                const unsigned kch = 4 * dkb + 2 * blk + (p >> 1), vch = 4 * cb + 2 * blk + (p >> 1);
                const s16x4 alo = vtr(Kl + tile * 8192 + offk64(r_lo, kch) + 8 * (p & 1)), ahi = vtr(Kl + tile * 8192 + offk64(r_hi, kch) + 8 * (p & 1));
                const s16x4 blo = vtr(Vl + tile * 16384 + offb(r_lo, vch) + 8 * (p & 1)), bhi = vtr(Vl + tile * 16384 + offb(r_hi, vch) + 8 * (p & 1));
                const bf16x8 af = {alo[0], alo[1], alo[2], alo[3], ahi[0], ahi[1], ahi[2], ahi[3]};
                const bf16x8 bfv = {blo[0], blo[1], blo[2], blo[3], bhi[0], bhi[1], bhi[2], bhi[3]};
                acc = MFMA32(af, bfv, acc);
            }
            if (tile == 0) { const float g64 = exp2f(l2g * 64.f);
#pragma unroll
                for (int r = 0; r < 16; ++r) acc[r] *= g64; }
        }
        bf16_t* orow = kvt + (size_t)(32 * cb + (lane & 31)) * 64 + 32 * dkb + 4 * hi;
#pragma unroll
        for (int g4 = 0; g4 < 4; ++g4) {
            u32x2 w; w.x = cvtpk(acc[4 * g4], acc[4 * g4 + 1]); w.y = cvtpk(acc[4 * g4 + 2], acc[4 * g4 + 3]);
            *(u32x2*)(orow + 8 * g4) = w;
        }
    }
#undef RS_LOAD
}
DI void retention_scan_unit(const Ptrs& P, int u, int tid) {
    const int gi = u * 512 + tid, bh = gi >> 10, within = gi & 1023, h = bh & 7;
    bf16_t* base = (bf16_t*)(P.ws + WS_KVT) + (size_t)bh * 16 * 8192 + within * 8;
    const float g128 = exp2f(log2f(1.f - exp2f(-5.f - (float)h)) * 128.f);
    u32x4 v[15];
#pragma unroll
    for (int c = 0; c < 15; ++c) v[c] = *(const u32x4*)(base + c * 8192);
    float a[8];
#pragma unroll
    for (int j = 0; j < 8; ++j) a[j] = 0.f;
#pragma unroll
    for (int c = 0; c < 15; ++c) {
        const u32x4 w = v[c];
        const float f[8] = {bflo(w.x), bfhi(w.x), bflo(w.y), bfhi(w.y), bflo(w.z), bfhi(w.z), bflo(w.w), bfhi(w.w)};
#pragma unroll
        for (int j = 0; j < 8; ++j) a[j] = a[j] * g128 + f[j];
        *(u32x4*)(base + c * 8192) = pack8(a);
    }
}
DI void retention_out_unit(ldsb* lds, const Ptrs& P, int b, int h, int jp, int tid) {
    const int lane = tid & 63, wid = __builtin_amdgcn_readfirstlane(tid >> 6), r32 = lane & 31, hi = lane >> 5;
    const bf16_t* proj = (const bf16_t*)(P.ws + WS_PROJ);
    const bf16_t* kvt = (const bf16_t*)(P.ws + WS_KVT) + ((size_t)((b * 8 + h) * 16)) * 128 * 64;
    bf16_t* mix = (bf16_t*)(P.ws + WS_MIX);
    ldsb* Kl = lds; ldsb* Vl = lds + 32768; ldsb* Rl = lds + 98304;
    const float l2g = log2f(1.f - exp2f(-5.f - (float)h));
    const int c0 = 2 * jp; const size_t row0 = (size_t)b * SEQ + 128 * c0;
    const int cw = wid >> 2, rb = wid & 3;
    const int Tq0 = 128 * (c0 + cw) + 32 * rb, tq = Tq0 + r32; const size_t rowq = (size_t)b * SEQ + tq;
    bf16x8 qf[4];
    __syncthreads();
    {
        u32x4 kq[4], vq[8], r0[2], r1[2];
        {
            const bf16_t* qp = proj + rowq * NPAD + C_RQ + h * 64 + 8 * hi;
#pragma unroll
            for (int s4 = 0; s4 < 4; ++s4) qf[s4] = *(const bf16x8*)(qp + 16 * s4);
        }
#pragma unroll
        for (int i = 0; i < 4; ++i) { const int ci = tid + 512 * i, row = ci >> 3, ch = ci & 7; kq[i] = *(const u32x4*)(proj + (row0 + row) * NPAD + C_RK + h * 64 + 8 * ch); }
#pragma unroll
        for (int i = 0; i < 8; ++i) { const int ci = tid + 512 * i, row = ci >> 4, ch = ci & 15; vq[i] = *(const u32x4*)(proj + (row0 + row) * NPAD + C_RV + h * 128 + 8 * ch); }
#pragma unroll
        for (int i = 0; i < 2; ++i) {
            const int ci = tid + 512 * i, row = ci >> 3, ch = ci & 7;
            r0[i] = u32x4{0u, 0u, 0u, 0u};
            if (c0 > 0) r0[i] = *(const u32x4*)(kvt + ((size_t)(c0 - 1) * 128 + row) * 64 + 8 * ch);
            r1[i] = *(const u32x4*)(kvt + ((size_t)c0 * 128 + row) * 64 + 8 * ch);
        }
        __builtin_amdgcn_sched_barrier(0);
#pragma unroll
        for (int i = 0; i < 4; ++i) { const int ci = tid + 512 * i, row = ci >> 3, ch = ci & 7; *(LAS u32x4*)(Kl + (row >> 6) * 8192 + offk64(row & 63, ch)) = kq[i]; }
#pragma unroll
        for (int i = 0; i < 8; ++i) { const int ci = tid + 512 * i, row = ci >> 4, ch = ci & 15; *(LAS u32x4*)(Vl + (row >> 6) * 16384 + offb(row & 63, ch)) = vq[i]; }
#pragma unroll
        for (int i = 0; i < 2; ++i) { const int ci = tid + 512 * i, row = ci >> 3, ch = ci & 7; *(LAS u32x4*)(Rl + offk64(row, ch)) = r0[i]; *(LAS u32x4*)(Rl + 16384 + offk64(row, ch)) = r1[i]; }
    }
    __syncthreads();
    f32x16 o[4];
#pragma unroll
    for (int c = 0; c < 4; ++c)
#pragma unroll
        for (int r = 0; r < 16; ++r) o[c][r] = 0.f;
    {
        ldsb* Rc = Rl + cw * 16384;
#pragma unroll
        for (int c = 0; c < 4; ++c)
#pragma unroll
            for (int s4 = 0; s4 < 4; ++s4) {
                const bf16x8 rf = *(LAS bf16x8*)(Rc + offk64(32 * c + r32, 2 * s4 + hi));
                o[c] = MFMA32(qf[s4], rf, o[c]);
            }
        const float gx = exp2f(l2g * (float)(32 * rb + 1));
#pragma unroll
        for (int c = 0; c < 4; ++c)
#pragma unroll
            for (int r = 0; r < 16; ++r) o[c][r] *= gx;
    }
#pragma unroll
    for (int kt = 0; kt < 2; ++kt) {
        const int Tk0 = 128 * (c0 + cw) + 64 * kt;
        if (Tk0 <= Tq0 + 31) {
            ldsb* Kt = Kl + (2 * cw + kt) * 8192; ldsb* Vt = Vl + (2 * cw + kt) * 16384;
            f32x16 p0, p1;
#pragma unroll
            for (int r = 0; r < 16; ++r) { p0[r] = 0.f; p1[r] = 0.f; }
            qk64(p0, p1, Kt, qf, r32, hi);
            const float cst = exp2f(l2g * (float)(Tq0 - Tk0 - 63));
#pragma unroll
            for (int r = 0; r < 16; ++r) {
                const int kv0 = Tk0 + crow(r, hi);
                p0[r] = (kv0 <= tq) ? p0[r] * cst : 0.f;
                p1[r] = (kv0 + 32 <= tq) ? p1[r] * cst : 0.f;
            }
            pv128(o, p0, p1, Vt, lane);
        }
    }
    const float* gn = P.ret_gn_g;
    float mu[16], rstd[16];
#pragma unroll
    for (int r = 0; r < 16; ++r) {
        float s1 = (o[0][r] + o[1][r]) + (o[2][r] + o[3][r]);
        s1 = half_sum(s1);
        mu[r] = s1 * (1.f / 128.f);
        float dv = 0.f;
#pragma unroll
        for (int c = 0; c < 4; ++c) { const float d = o[c][r] - mu[r]; dv += d * d; }
        dv = half_sum(dv);
        rstd[r] = rsqrtf(dv * (1.f / 128.f) + EPS);
    }
    unsigned short rga[4][16];
#pragma unroll
    for (int c = 0; c < 4; ++c)
#pragma unroll
        for (int r = 0; r < 16; ++r) rga[c][r] = proj[((size_t)b * SEQ + Tq0 + crow(r, hi)) * NPAD + C_RG + h * 128 + 32 * c + r32];
    float gcols[4];
#pragma unroll
    for (int c = 0; c < 4; ++c) gcols[c] = gn[h * 128 + 32 * c + r32];
    __builtin_amdgcn_sched_barrier(0);
#pragma unroll
    for (int c = 0; c < 4; ++c) {
        const int col = h * 128 + 32 * c + r32;
        const unsigned short (&rgv)[16] = rga[c];
        const float gcol = gcols[c];
#pragma unroll
        for (int r = 0; r < 16; ++r) {
            const float rg = bf2f(rgv[r]);
            const float y = (o[c][r] - mu[r]) * rstd[r] * gcol;
            const float sg = rg / (1.f + __expf(-rg));
            mix[((size_t)b * SEQ + Tq0 + crow(r, hi)) * DM + col] = (bf16_t)f2bf(y * sg);
        }
        __builtin_amdgcn_sched_barrier(0);
    }
}


DI void compress_step1(ldsb* lds, const Ptrs& P, int kvs, int bg, int ks, int tid) {
    const int lane = tid & 63, wid = __builtin_amdgcn_readfirstlane(tid >> 6), r32 = lane & 31, hi = lane >> 5;
    const int b = bg >> 1, g = bg & 1;
    const bf16_t* proj = (const bf16_t*)(P.ws + WS_PROJ);
    const bf16_t* w1t = (const bf16_t*)(P.ws + WS_W1T) + (size_t)kvs * 256 * 4096;
    float* part = (float*)(P.ws + (kvs ? WS_CPART1 : WS_CPART0)) + ((size_t)(bg * 8 + ks) * 128) * 256;
    ldsb* Al = lds;
    const bf16_t* asrc = proj + ((size_t)b * SEQ + 16 * (tid >> 4)) * NPAD + C_KV + (kvs * 2 + g) * 128 + 8 * (tid & 15);
    const bf16_t* brow = w1t + (size_t)(32 * wid + r32) * 4096 + 8 * hi;
    f32x16 acc[4];
#pragma unroll
    for (int rb = 0; rb < 4; ++rb)
#pragma unroll
        for (int r = 0; r < 16; ++r) acc[rb][r] = 0.f;
    u32x4 areg[4], breg[8];
    const int l0 = 4 * ks;
#define C1_LOAD(l) do { _Pragma("unroll") for (int i_ = 0; i_ < 4; ++i_) { areg[i_] = *(const u32x4*)(asrc + ((size_t)(512 * i_) + (l)) * NPAD); } \
                        _Pragma("unroll") for (int s_ = 0; s_ < 8; ++s_) breg[s_] = *(const u32x4*)(brow + (l) * 128 + 16 * s_); } while (0)
    C1_LOAD(l0);
    for (int li = 0; li < 4; ++li) {
        __syncthreads();
#pragma unroll
        for (int i = 0; i < 4; ++i) {
            const int row = (tid >> 4) + 32 * i; u32x4 v = areg[i];
            if (row == 127) { v.x = 0u; v.y = 0u; v.z = 0u; v.w = 0u; }
            *(LAS u32x4*)(Al + offb(row, tid & 15)) = v;
        }
        bf16x8 bf[8];
#pragma unroll
        for (int s = 0; s < 8; ++s) bf[s] = __builtin_bit_cast(bf16x8, breg[s]);
        if (li < 3) C1_LOAD(l0 + li + 1);
        __syncthreads();
#pragma unroll
        for (int rb = 0; rb < 4; ++rb)
#pragma unroll
            for (int s = 0; s < 8; ++s) {
                const bf16x8 af = *(LAS bf16x8*)(Al + offb(32 * rb + r32, 2 * s + hi));
                acc[rb] = MFMA32(af, bf[s], acc[rb]);
            }
    }
#undef C1_LOAD
#pragma unroll
    for (int rb = 0; rb < 4; ++rb)
#pragma unroll
        for (int r = 0; r < 16; ++r) part[(size_t)(32 * rb + crow(r, hi)) * 256 + 32 * wid + r32] = acc[rb][r];
}
DI void compress_step2(ldsb* lds, const Ptrs& P, int kvs, int bg, int cb, int tid) {
    const int lane = tid & 63, wid = __builtin_amdgcn_readfirstlane(tid >> 6), r32 = lane & 31, hi = lane >> 5;
    const bf16_t* w2t = (const bf16_t*)(P.ws + WS_TAB + TAB_W2T) + (size_t)kvs * 128 * 256;
    const float* cbias = (const float*)(P.ws + WS_CBP) + (size_t)kvs * 64 * 256;
    const float* part = (const float*)(P.ws + (kvs ? WS_CPART1 : WS_CPART0)) + ((size_t)(bg * 8) * 128) * 256;
    bf16_t* outp = (bf16_t*)(P.ws + (kvs ? WS_VCMP : WS_KCMP)) + ((size_t)bg * 128) * 128;
    const int n = 32 * wid + r32;
    float bn = 0.f;
    {
        float bv[64];
#pragma unroll
        for (int kc = 0; kc < 64; ++kc) bv[kc] = cbias[kc * 256 + n];
#pragma unroll
        for (int kc = 0; kc < 64; ++kc) bn += bv[kc];
    }
    LAS bf16_t* hid = (LAS bf16_t*)(lds + L_HID);
    __syncthreads();
#pragma unroll
    for (int rh = 0; rh < 2; ++rh) {
        float pv[8][8];
#pragma unroll
        for (int r8 = 0; r8 < 8; ++r8)
#pragma unroll
            for (int k8 = 0; k8 < 8; ++k8) pv[r8][k8] = part[((size_t)k8 * 128 + 32 * cb + crow(8 * rh + r8, hi)) * 256 + n];
        __builtin_amdgcn_sched_barrier(0);
#pragma unroll
        for (int r8 = 0; r8 < 8; ++r8) {
            float a = bn;
#pragma unroll
            for (int k8 = 0; k8 < 8; ++k8) a += pv[r8][k8];
            hid[crow(8 * rh + r8, hi) * 256 + n] = (bf16_t)f2bf(gelu_tanh(a));
        }
    }
    __syncthreads();
    if (wid < 4) {
        f32x16 o2;
#pragma unroll
        for (int r = 0; r < 16; ++r) o2[r] = 0.f;
#pragma unroll
        for (int s = 0; s < 16; ++s) {
            const bf16x8 af = *(LAS bf16x8*)(hid + r32 * 256 + 16 * s + 8 * hi);
            const bf16x8 bfr = *(const bf16x8*)(w2t + (size_t)(32 * wid + r32) * 256 + 16 * s + 8 * hi);
            o2 = MFMA32(af, bfr, o2);
        }
#pragma unroll
        for (int r = 0; r < 16; ++r) outp[(size_t)(cb * 32 + crow(r, hi)) * 128 + 32 * wid + r32] = (bf16_t)f2bf(o2[r]);
    }
}

constexpr float NEGF = -1e30f;
DI void scale_rows(f32x16 (&o)[4], float f, LAS float* wsf, int r32, int hi) {
    if (hi == 0) wsf[r32] = f;
    asm volatile("s_waitcnt lgkmcnt(0)" ::: "memory");
#pragma unroll
    for (int r = 0; r < 16; ++r) {
        const float fr = wsf[crow(r, hi)];
#pragma unroll
        for (int c = 0; c < 4; ++c) o[c][r] *= fr;
    }
    asm volatile("s_waitcnt lgkmcnt(0)" ::: "memory");
}
template <int MODE>
DI void acc_rows(rsrc_t otr, unsigned otv, f32x16 (&o)[4], float f, LAS float* wsf, int r32, int hi) {
    if (hi == 0) wsf[r32] = f;
    asm volatile("s_waitcnt lgkmcnt(0)" ::: "memory");
    float fr[16];
#pragma unroll
    for (int r = 0; r < 16; ++r) fr[r] = wsf[crow(r, hi)];
    if (MODE < 2) {
#pragma unroll
        for (int c = 0; c < 4; ++c)
#pragma unroll
            for (int r = 0; r < 16; ++r)
                __builtin_amdgcn_raw_buffer_store_b32(__builtin_bit_cast(unsigned, fr[r] * o[c][r]), otr, (int)otv, MODE * 16384 + (c * 16 + r) * 256, 0);
    } else {
#pragma unroll
        for (int ch = 0; ch < 2; ++ch) {
            float pa[32], pb[32];
#pragma unroll
            for (int i = 0; i < 32; ++i) {
                pa[i] = __builtin_bit_cast(float, __builtin_amdgcn_raw_buffer_load_b32(otr, (int)otv, (ch * 32 + i) * 256, 0));
                pb[i] = __builtin_bit_cast(float, __builtin_amdgcn_raw_buffer_load_b32(otr, (int)otv, 16384 + (ch * 32 + i) * 256, 0));
            }
            __builtin_amdgcn_sched_barrier(0);
#pragma unroll
            for (int i = 0; i < 32; ++i) { const int c = 2 * ch + (i >> 4), r = i & 15; o[c][r] = fr[r] * o[c][r] + (pa[i] + pb[i]); }
            __builtin_amdgcn_sched_barrier(0);
        }
    }
    asm volatile("s_waitcnt lgkmcnt(0)" ::: "memory");
}
template <int MODE>
DI void attn_step(f32x16 (&o)[4], float& m, float& l, ldsb* Kl, ldsb* Vl, ldsb* Ql, const LAS float* lutl, LAS float* wsf,
                  int t, int kpos0, int hh, bool selbit, int lane, int r32, int hi) {
    f32x16 p0, p1;
#pragma unroll
    for (int r = 0; r < 16; ++r) { p0[r] = 0.f; p1[r] = 0.f; }
    qk128l(p0, p1, Kl, Ql, lane, r32, hi);
    float tmax = NEGF;
    const int tw0 = __builtin_amdgcn_readfirstlane(t) & ~7;
    const bool farq = (tw0 - (kpos0 + 63) >= 128) && (MODE == 0 || (tw0 + 7 - kpos0) < 512);
    float cadd = 0.f;
    if (farq) {
        const float cb = lutl[127 * 8 + hh];
        float mx = fmaxf(p0[0], p1[0]);
#pragma unroll
        for (int r = 1; r < 16; ++r) mx = fmaxf(fmaxf(mx, p0[r]), p1[r]);
        const bool lane_ok = (MODE == 1) || selbit;
        tmax = lane_ok ? mx + cb : NEGF;
        cadd = lane_ok ? cb : NEGF;
    } else {
        int tb = t - kpos0 - 4 * hi; asm volatile("" : "+v"(tb));
        float b0[16], b1[16];
#pragma unroll
        for (int r = 0; r < 16; ++r) {
            const int d0 = tb - ((r & 3) + 8 * (r >> 2)), d1 = d0 - 32;
            const int i0 = d0 < 0 ? 0 : (d0 > 127 ? 127 : d0), i1 = d1 < 0 ? 0 : (d1 > 127 ? 127 : d1);
            b0[r] = lutl[i0 * 8 + hh]; b1[r] = lutl[i1 * 8 + hh];
        }
        asm volatile("" : "+v"(b0[0]), "+v"(b0[1]), "+v"(b0[2]), "+v"(b0[3]), "+v"(b0[4]), "+v"(b0[5]), "+v"(b0[6]), "+v"(b0[7]), "+v"(b0[8]), "+v"(b0[9]), "+v"(b0[10]), "+v"(b0[11]), "+v"(b0[12]), "+v"(b0[13]), "+v"(b0[14]), "+v"(b0[15]));
        asm volatile("" : "+v"(b1[0]), "+v"(b1[1]), "+v"(b1[2]), "+v"(b1[3]), "+v"(b1[4]), "+v"(b1[5]), "+v"(b1[6]), "+v"(b1[7]), "+v"(b1[8]), "+v"(b1[9]), "+v"(b1[10]), "+v"(b1[11]), "+v"(b1[12]), "+v"(b1[13]), "+v"(b1[14]), "+v"(b1[15]));
#pragma unroll
        for (int r = 0; r < 16; ++r) {
            const int d0 = tb - ((r & 3) + 8 * (r >> 2)), d1 = d0 - 32;
            const bool v0 = (MODE == 0) ? (selbit && d0 >= 0) : (d0 >= 0 && d0 < 512);
            const bool v1 = (MODE == 0) ? (selbit && d1 >= 0) : (d1 >= 0 && d1 < 512);
            p0[r] = v0 ? p0[r] + b0[r] : NEGF;
            p1[r] = v1 ? p1[r] + b1[r] : NEGF;
            tmax = fmaxf(tmax, fmaxf(p0[r], p1[r]));
        }
    }
    tmax = fmaxf(tmax, __shfl_xor(tmax, 32));
    if (__any(tmax > m + 8.f)) {
        const float mnew = (tmax > m + 8.f) ? tmax : m;
        const float f = __builtin_amdgcn_exp2f(m - mnew);
        l *= f; m = mnew;
        scale_rows(o, f, wsf, r32, hi);
    }
    const float csub = cadd - ((m < -1e29f) ? 0.f : m);
    float rs = 0.f;
#pragma unroll
    for (int r = 0; r < 16; ++r) {
        const float e0 = __builtin_amdgcn_exp2f(p0[r] + csub), e1 = __builtin_amdgcn_exp2f(p1[r] + csub);
        p0[r] = e0; p1[r] = e1; rs += e0 + e1;
    }
    l += rs;
    pv128(o, p0, p1, Vl, lane);
}

DI void nsa_unit(ldsb* lds, const Ptrs& P, int b, int g, int qi, int tid) {
    const int lane = tid & 63, wid = __builtin_amdgcn_readfirstlane(tid >> 6), r32 = lane & 31, hi = lane >> 5;
    const bf16_t* proj = (const bf16_t*)(P.ws + WS_PROJ);
    const bf16_t* kcmp = (const bf16_t*)(P.ws + WS_KCMP) + (size_t)(b * 2 + g) * 128 * 128;
    const bf16_t* vcmp = (const bf16_t*)(P.ws + WS_VCMP) + (size_t)(b * 2 + g) * 128 * 128;
    const float* lutg = (const float*)(P.ws + WS_TAB + TAB_LUT);
    bf16_t* mix = (bf16_t*)(P.ws + WS_MIX);
    ldsb* Kl = lds + L_K; ldsb* Vl = lds + L_V;
    LAS float* wsf = (LAS float*)(lds + L_WSF) + wid * 64;
    LAS float* lutl = (LAS float*)(lds + L_LUT);
    LAS unsigned* misc = (LAS unsigned*)(lds + L_MISC);
    const int head = r32 >> 3, tl = r32 & 7, hh = g * 4 + head;
    const int t = 64 * qi + 8 * wid + tl; const size_t row = (size_t)b * SEQ + t;
    __syncthreads();
    const int ntile = ((64 * qi + 63) >= 1055) ? 2 : 1;
    ldsb* Ql = lds + L_Q + wid * 8192;
    {
        const float l0 = lutg[tid], l1 = lutg[tid + NTHREADS];
        const bf16_t* qp = proj + row * NPAD + C_NQ + hh * 128 + 8 * hi;
        bf16x8 qv[8];
#pragma unroll
        for (int s = 0; s < 8; ++s) qv[s] = *(const bf16x8*)(qp + 16 * s);
        const int srow = tid >> 4, sch = tid & 15;
        u32x4 ck[4], cv[4];
#pragma unroll
        for (int i = 0; i < 2; ++i) { ck[i] = *(const u32x4*)(kcmp + (size_t)(srow + 32 * i) * 128 + 8 * sch); cv[i] = *(const u32x4*)(vcmp + (size_t)(srow + 32 * i) * 128 + 8 * sch); }
        if (ntile == 2) {
#pragma unroll
            for (int i = 0; i < 2; ++i) { ck[2 + i] = *(const u32x4*)(kcmp + (size_t)(64 + srow + 32 * i) * 128 + 8 * sch); cv[2 + i] = *(const u32x4*)(vcmp + (size_t)(64 + srow + 32 * i) * 128 + 8 * sch); }
        }
        __builtin_amdgcn_sched_barrier(0);
        lutl[tid] = l0 * 1.4426950408889634f; lutl[tid + NTHREADS] = l1 * 1.4426950408889634f;
        if (tid == 0) misc[0] = 0u;
#pragma unroll
        for (int s = 0; s < 8; ++s) *(LAS bf16x8*)(Ql + (s * 64 + lane) * 16) = qv[s];
#pragma unroll
        for (int i = 0; i < 2; ++i) { *(LAS u32x4*)(Kl + offb(srow + 32 * i, sch)) = ck[i]; *(LAS u32x4*)(Vl + offb(srow + 32 * i, sch)) = cv[i]; }
        if (ntile == 2) {
#pragma unroll
            for (int i = 0; i < 2; ++i) { *(LAS u32x4*)(lds + L_K2 + offb(srow + 32 * i, sch)) = ck[2 + i]; *(LAS u32x4*)(lds + L_V2 + offb(srow + 32 * i, sch)) = cv[2 + i]; }
        }
    }
    float g0, g1, g2;
    {
        const bf16_t* gp = proj + row * NPAD + C_GATE + hh * 3;
        g0 = 1.f / (1.f + __expf(-bf2f(gp[0]))); g1 = 1.f / (1.f + __expf(-bf2f(gp[1]))); g2 = 1.f / (1.f + __expf(-bf2f(gp[2])));
    }
    const rsrc_t otr = mk_rsrc(P.ws + ((blockIdx.x & 128u) ? WS_NSCR1 : WS_NSCR0) + (size_t)(blockIdx.x & 127u) * 262144, 262144);
    const unsigned otv = (unsigned)((wid * 8192 + lane) * 4);
    unsigned selmask;
    u32x4 sk0, sk1, sv0, sv1;
    {
        ldsb* K2l = lds + L_K2; ldsb* V2l = lds + L_V2;
        __syncthreads();
        f32x16 pa0, pa1, pb0, pb1;
#pragma unroll
        for (int r = 0; r < 16; ++r) { pa0[r] = 0.f; pa1[r] = 0.f; pb0[r] = 0.f; pb1[r] = 0.f; }
        qk128l(pa0, pa1, Kl, Ql, lane, r32, hi);
        if (ntile == 2) qk128l(pb0, pb1, K2l, Ql, lane, r32, hi);
        float tmax = NEGF;
#define CMP_BIAS(P0, P1, TI) { int tb = t - 31 - 16 * (64 * (TI) + 4 * hi); asm volatile("" : "+v"(tb)); \
            _Pragma("unroll") for (int r = 0; r < 16; ++r) { \
                const int d0 = tb - 16 * ((r & 3) + 8 * (r >> 2)), d1 = d0 - 512; \
                const int i0 = d0 < 0 ? 0 : (d0 > 127 ? 127 : d0), i1 = d1 < 0 ? 0 : (d1 > 127 ? 127 : d1); \
                float b0 = lutl[i0 * 8 + hh], b1 = lutl[i1 * 8 + hh]; asm volatile("" : "+v"(b0), "+v"(b1)); \
                P0[r] = (d0 >= 0) ? P0[r] + b0 : NEGF; P1[r] = (d1 >= 0) ? P1[r] + b1 : NEGF; \
                tmax = fmaxf(tmax, fmaxf(P0[r], P1[r])); } }
        CMP_BIAS(pa0, pa1, 0)
        if (ntile == 2) { CMP_BIAS(pb0, pb1, 1) } else {
#pragma unroll
            for (int r = 0; r < 16; ++r) { pb0[r] = NEGF; pb1[r] = NEGF; }
        }
#undef CMP_BIAS
        tmax = fmaxf(tmax, __shfl_xor(tmax, 32));
        const float m = tmax;
        float l = 0.f;
#define CMP_EXP(P) { _Pragma("unroll") for (int r = 0; r < 16; ++r) { const float e = __builtin_amdgcn_exp2f(fminf(P[r] - m, 0.f)); P[r] = (P[r] > -1e29f) ? e : 0.f; l += P[r]; } }
        CMP_EXP(pa0) CMP_EXP(pa1) CMP_EXP(pb0) CMP_EXP(pb1)
#undef CMP_EXP
        l += __shfl_xor(l, 32);
        const float inv = 1.f / fmaxf(l, 1e-30f);
#pragma unroll
        for (int r = 0; r < 16; ++r) { pa0[r] *= inv; pa1[r] *= inv; pb0[r] *= inv; pb1[r] *= inv; }
        f32x16 o[4];
#pragma unroll
        for (int c = 0; c < 4; ++c)
#pragma unroll
            for (int r = 0; r < 16; ++r) o[c][r] = 0.f;
        float A[4][4], Lv[4][4];
#pragma unroll
        for (int gq = 0; gq < 4; ++gq) {
            Lv[0][gq] = 0.5f * pa0[4 * gq + 3]; A[0][gq] = (pa0[4 * gq] + pa0[4 * gq + 1]) + (pa0[4 * gq + 2] + Lv[0][gq]);
            Lv[1][gq] = 0.5f * pa1[4 * gq + 3]; A[1][gq] = (pa1[4 * gq] + pa1[4 * gq + 1]) + (pa1[4 * gq + 2] + Lv[1][gq]);
            Lv[2][gq] = 0.5f * pb0[4 * gq + 3]; A[2][gq] = (pb0[4 * gq] + pb0[4 * gq + 1]) + (pb0[4 * gq + 2] + Lv[2][gq]);
            Lv[3][gq] = 0.5f * pb1[4 * gq + 3]; A[3][gq] = (pb1[4 * gq] + pb1[4 * gq + 1]) + (pb1[4 * gq + 2] + Lv[3][gq]);
        }
        pv128(o, pa0, pa1, Vl, lane);
        if (ntile == 2) pv128(o, pb0, pb1, V2l, lane);
        {
            const bf16_t* skb = proj + (size_t)b * SEQ * NPAD + C_KV + (2 * 2 + g) * 128 + (size_t)(tid >> 4) * NPAD + 8 * (tid & 15);
            const bf16_t* svb = proj + (size_t)b * SEQ * NPAD + C_KV + (3 * 2 + g) * 128 + (size_t)(tid >> 4) * NPAD + 8 * (tid & 15);
            sk0 = *(const u32x4*)(skb); sk1 = *(const u32x4*)(skb + (size_t)32 * NPAD);
            sv0 = *(const u32x4*)(svb); sv1 = *(const u32x4*)(svb + (size_t)32 * NPAD);
        }
        acc_rows<0>(otr, otv, o, g0, wsf, r32, hi);
        if (qi < 16) {
            selmask = (1u << (qi + 1)) - 1u;
        } else {
            float imp[4][4];
#pragma unroll
            for (int i = 0; i < 4; ++i)
#pragma unroll
                for (int gq = 0; gq < 4; ++gq) {
                    const float rc = __shfl_xor(Lv[i][gq], 32);
                    float prev_for_hi0;
                    if (gq > 0) prev_for_hi0 = __shfl_xor(Lv[i][gq - 1], 32);
                    else if (i > 0) prev_for_hi0 = __shfl_xor(Lv[i - 1][3], 32);
                    else prev_for_hi0 = 0.f;
                    imp[i][gq] = A[i][gq] + (hi ? rc : prev_for_hi0);
                }
#pragma unroll
            for (int i = 0; i < 4; ++i)
#pragma unroll
                for (int gq = 0; gq < 4; ++gq) { float v = imp[i][gq]; v += __shfl_xor(v, 8); v += __shfl_xor(v, 16); imp[i][gq] = v; }
#pragma unroll
            for (int i = 0; i < 4; ++i)
#pragma unroll
                for (int gq = 0; gq < 4; ++gq) {
                    const int j = 8 * i + 2 * gq + hi;
                    float v = imp[i][gq];
                    if (j == 0 || j == qi || j == qi - 1) v = 1e9f;
                    if (j > qi) v = -1e9f;
                    imp[i][gq] = v;
                }
            float oth[4][4];
#pragma unroll
            for (int i = 0; i < 4; ++i)
#pragma unroll
                for (int gq = 0; gq < 4; ++gq) oth[i][gq] = __shfl_xor(imp[i][gq], 32);
            unsigned bits = 0u;
            int headv = head, hiv = hi; asm volatile("" : "+v"(headv), "+v"(hiv));
#pragma unroll
            for (int gq = 0; gq < 4; ++gq) {
                const unsigned m0 = (unsigned)(-(int)(headv == 0)), m1 = (unsigned)(-(int)(headv == 1)), m2 = (unsigned)(-(int)(headv == 2)), m3 = (unsigned)(-(int)(headv == 3));
                const float x = __builtin_bit_cast(float, (__builtin_bit_cast(unsigned, imp[0][gq]) & m0) | (__builtin_bit_cast(unsigned, imp[1][gq]) & m1) |
                                                          (__builtin_bit_cast(unsigned, imp[2][gq]) & m2) | (__builtin_bit_cast(unsigned, imp[3][gq]) & m3));
                const int j = 8 * headv + 2 * gq + hiv;
                int rank = 0;
#pragma unroll
                for (int i2 = 0; i2 < 4; ++i2)
#pragma unroll
                    for (int g2q = 0; g2q < 4; ++g2q) {
                        const int jm = 8 * i2 + 2 * g2q + hiv, jo = 8 * i2 + 2 * g2q + (1 - hiv);
                        const float vm = imp[i2][g2q], vo = oth[i2][g2q];
                        rank += (vm > x || (vm == x && jm < j)) ? 1 : 0;
                        rank += (vo > x || (vo == x && jo < j)) ? 1 : 0;
                    }
                if (rank < 16 && j <= qi) bits |= (1u << j);
            }
            bits |= __shfl_xor(bits, 8); bits |= __shfl_xor(bits, 16); bits |= __shfl_xor(bits, 32);
            selmask = bits;
        }
    }
    atomicOr((unsigned*)misc, selmask);
    __syncthreads();
    const unsigned wgmask = misc[0];
    u32x4 wk0, wk1, wv0, wv1;
    {
        f32x16 o[4];
#pragma unroll
        for (int c = 0; c < 4; ++c)
#pragma unroll
            for (int r = 0; r < 16; ++r) o[c][r] = 0.f;
        float m = NEGF, l = 0.f;
        const bf16_t* kb = proj + (size_t)b * SEQ * NPAD + C_KV + (2 * 2 + g) * 128;
        const bf16_t* vb = proj + (size_t)b * SEQ * NPAD + C_KV + (3 * 2 + g) * 128;
        const bf16_t* ks0 = kb + (size_t)(tid >> 4) * NPAD + 8 * (tid & 15); const bf16_t* vs0 = vb + (size_t)(tid >> 4) * NPAD + 8 * (tid & 15);
        unsigned rem = wgmask & ((qi == 31) ? 0xffffffffu : ((2u << qi) - 1u));
        int j = 0;
        u32x4 kr0 = sk0, kr1 = sk1, vr0 = sv0, vr1 = sv1;
        const unsigned lo0 = offb(tid >> 4, tid & 15), lo1 = offb(32 + (tid >> 4), tid & 15);
        rem &= rem - 1u;
        __syncthreads();
        *(LAS u32x4*)(Kl + lo0) = kr0; *(LAS u32x4*)(Kl + lo1) = kr1; *(LAS u32x4*)(Vl + lo0) = vr0; *(LAS u32x4*)(Vl + lo1) = vr1;
        int jc = 0, cur = 0;
        if (rem) {
            j = __builtin_ctz(rem);
            kr0 = *(const u32x4*)(ks0 + (size_t)(64 * j) * NPAD); kr1 = *(const u32x4*)(ks0 + (size_t)(64 * j + 32) * NPAD);
            vr0 = *(const u32x4*)(vs0 + (size_t)(64 * j) * NPAD); vr1 = *(const u32x4*)(vs0 + (size_t)(64 * j + 32) * NPAD);
        }
        for (;;) {
            __syncthreads();
            const bool more = rem != 0u; const int jn = j;
            ldsb* Kc = cur ? lds + L_K2 : Kl; ldsb* Vc = cur ? lds + L_V2 : Vl;
            if (more) {
                rem &= rem - 1u;
                ldsb* Kn = cur ? Kl : lds + L_K2; ldsb* Vn = cur ? Vl : lds + L_V2;
                *(LAS u32x4*)(Kn + lo0) = kr0; *(LAS u32x4*)(Kn + lo1) = kr1; *(LAS u32x4*)(Vn + lo0) = vr0; *(LAS u32x4*)(Vn + lo1) = vr1;
                if (rem) {
                    j = __builtin_ctz(rem);
                    kr0 = *(const u32x4*)(ks0 + (size_t)(64 * j) * NPAD); kr1 = *(const u32x4*)(ks0 + (size_t)(64 * j + 32) * NPAD);
                    vr0 = *(const u32x4*)(vs0 + (size_t)(64 * j) * NPAD); vr1 = *(const u32x4*)(vs0 + (size_t)(64 * j + 32) * NPAD);
                }
            }
            attn_step<0>(o, m, l, Kc, Vc, Ql, lutl, wsf, t, 64 * jc, hh, ((selmask >> jc) & 1u) != 0u, lane, r32, hi);
            if (!more) break;
            jc = jn; cur ^= 1;
        }
        {
            const bf16_t* wkb = proj + (size_t)b * SEQ * NPAD + C_KV + (4 * 2 + g) * 128 + (size_t)(tid >> 4) * NPAD + 8 * (tid & 15);
            const bf16_t* wvb = proj + (size_t)b * SEQ * NPAD + C_KV + (5 * 2 + g) * 128 + (size_t)(tid >> 4) * NPAD + 8 * (tid & 15);
            const int jw = (qi > 8 ? qi - 8 : 0);
            wk0 = *(const u32x4*)(wkb + (size_t)(64 * jw) * NPAD); wk1 = *(const u32x4*)(wkb + (size_t)(64 * jw + 32) * NPAD);
            wv0 = *(const u32x4*)(wvb + (size_t)(64 * jw) * NPAD); wv1 = *(const u32x4*)(wvb + (size_t)(64 * jw + 32) * NPAD);
        }
        l += __shfl_xor(l, 32);
        acc_rows<1>(otr, otv, o, g1 / fmaxf(l, 1e-30f), wsf, r32, hi);
    }
    f32x16 ot[4];
    {
        f32x16 (&o)[4] = ot;
#pragma unroll
        for (int c = 0; c < 4; ++c)
#pragma unroll
            for (int r = 0; r < 16; ++r) o[c][r] = 0.f;
        float m = NEGF, l = 0.f;
        const bf16_t* kb = proj + (size_t)b * SEQ * NPAD + C_KV + (4 * 2 + g) * 128;
        const bf16_t* vb = proj + (size_t)b * SEQ * NPAD + C_KV + (5 * 2 + g) * 128;
        const bf16_t* ks0 = kb + (size_t)(tid >> 4) * NPAD + 8 * (tid & 15); const bf16_t* vs0 = vb + (size_t)(tid >> 4) * NPAD + 8 * (tid & 15);
        int j = (qi > 8 ? qi - 8 : 0);
        u32x4 kr0 = wk0, kr1 = wk1, vr0 = wv0, vr1 = wv1;
        const unsigned lo0 = offb(tid >> 4, tid & 15), lo1 = offb(32 + (tid >> 4), tid & 15);
        __syncthreads();
        *(LAS u32x4*)(Kl + lo0) = kr0; *(LAS u32x4*)(Kl + lo1) = kr1; *(LAS u32x4*)(Vl + lo0) = vr0; *(LAS u32x4*)(Vl + lo1) = vr1;
        if (j < qi) {
            kr0 = *(const u32x4*)(ks0 + (size_t)(64 * j + 64) * NPAD); kr1 = *(const u32x4*)(ks0 + (size_t)(64 * j + 96) * NPAD);
            vr0 = *(const u32x4*)(vs0 + (size_t)(64 * j + 64) * NPAD); vr1 = *(const u32x4*)(vs0 + (size_t)(64 * j + 96) * NPAD);
        }
        for (int cur = 0; ; ++j, cur ^= 1) {
            __syncthreads();
            ldsb* Kc = cur ? lds + L_K2 : Kl; ldsb* Vc = cur ? lds + L_V2 : Vl;
            if (j < qi) {
                ldsb* Kn = cur ? Kl : lds + L_K2; ldsb* Vn = cur ? Vl : lds + L_V2;
                *(LAS u32x4*)(Kn + lo0) = kr0; *(LAS u32x4*)(Kn + lo1) = kr1; *(LAS u32x4*)(Vn + lo0) = vr0; *(LAS u32x4*)(Vn + lo1) = vr1;
                if (j + 1 < qi) {
                    kr0 = *(const u32x4*)(ks0 + (size_t)(64 * j + 128) * NPAD); kr1 = *(const u32x4*)(ks0 + (size_t)(64 * j + 160) * NPAD);
                    vr0 = *(const u32x4*)(vs0 + (size_t)(64 * j + 128) * NPAD); vr1 = *(const u32x4*)(vs0 + (size_t)(64 * j + 160) * NPAD);
                }
            }
            attn_step<1>(o, m, l, Kc, Vc, Ql, lutl, wsf, t, 64 * j, hh, true, lane, r32, hi);
            if (j >= qi) break;
        }
        l += __shfl_xor(l, 32);
        acc_rows<2>(otr, otv, o, g2 / fmaxf(l, 1e-30f), wsf, r32, hi);
    }
    const float* og = P.nsa_out_g;
    float ogv[4][4];
#pragma unroll
    for (int hq = 0; hq < 4; ++hq)
#pragma unroll
        for (int c = 0; c < 4; ++c) ogv[hq][c] = og[(g * 4 + hq) * 128 + 32 * c + r32];
#pragma unroll
    for (int r = 0; r < 16; ++r) {
        float ss = (ot[0][r] * ot[0][r] + ot[1][r] * ot[1][r]) + (ot[2][r] * ot[2][r] + ot[3][r] * ot[3][r]);
        ss = half_sum(ss);
        const float rstd = rsqrtf(ss * (1.f / 128.f) + EPS);
        const int q = crow(r, hi), hq = q >> 3, tq = 64 * qi + 8 * wid + (q & 7);
        const size_t orow = (size_t)b * SEQ + tq;
#pragma unroll
        for (int c = 0; c < 4; ++c) {
            const int col = (g * 4 + hq) * 128 + 32 * c + r32;
            mix[orow * DM + 1024 + col] = (bf16_t)f2bf(ot[c][r] * rstd * ogv[r >> 2][c]);
        }
    }
}
DI unsigned f2sort(float f) { const unsigned u = __builtin_bit_cast(unsigned, f); return u ^ ((u >> 31) ? 0xffffffffu : 0x80000000u); }
DI float sort2f(unsigned s) { const unsigned u = s ^ ((s >> 31) ? 0x80000000u : 0xffffffffu); return __builtin_bit_cast(float, u); }
DI void ce_desc(unsigned& a, unsigned& b) { const unsigned t = a > b ? a : b; b = a > b ? b : a; a = t; }
template <int J> DI void bitonic_pass16(unsigned (&x)[16]) {
#pragma unroll
    for (int i = 0; i < 16; ++i) if ((i ^ J) > i) ce_desc(x[i], x[i ^ J]);
}
template <int K, int J> DI void bitonic_pass16k(unsigned (&x)[16]) {
#pragma unroll
    for (int i = 0; i < 16; ++i) if ((i ^ J) > i) { if ((i & K) == 0) ce_desc(x[i], x[i ^ J]); else ce_desc(x[i ^ J], x[i]); }
}
DI void bitonic_sort16(unsigned (&x)[16]) {
    bitonic_pass16k<2, 1>(x);
    bitonic_pass16k<4, 2>(x); bitonic_pass16k<4, 1>(x);
    bitonic_pass16k<8, 4>(x); bitonic_pass16k<8, 2>(x); bitonic_pass16k<8, 1>(x);
    bitonic_pass16<8>(x); bitonic_pass16<4>(x); bitonic_pass16<2>(x); bitonic_pass16<1>(x);
}
DI void bitonic_merge16(unsigned (&x)[16]) { bitonic_pass16<8>(x); bitonic_pass16<4>(x); bitonic_pass16<2>(x); bitonic_pass16<1>(x); }
DI void merge_top16(unsigned (&t)[16], const unsigned (&o)[16]) {
#pragma unroll
    for (int i = 0; i < 16; ++i) t[i] = t[i] > o[15 - i] ? t[i] : o[15 - i];
    bitonic_merge16(t);
}
template <int N> DI void merge_topN(unsigned (&t)[16], const unsigned (&o)[N]) {
#pragma unroll
    for (int i = 16 - N; i < 16; ++i) t[i] = t[i] > o[15 - i] ? t[i] : o[15 - i];
    bitonic_merge16(t);
}

DI void peer_tile(ldsb* lds, const Ptrs& P, int tile, int tid, bool first) {
    const int lane = tid & 63, wid = __builtin_amdgcn_readfirstlane(tid >> 6), r32 = lane & 31, hi = lane >> 5;
    const bf16_t* qpeer = (const bf16_t*)(P.ws + WS_PROJ);
    const bf16_t* skb = (const bf16_t*)(P.ws + WS_TAB + TAB_SK);
    const unsigned char* ub = P.ws + WS_UB; const unsigned char* vb = P.ws + WS_VB;
    const float* uinv = (const float*)(P.ws + WS_TAB + TAB_UINV); const float* vinv = (const float*)(P.ws + WS_TAB + TAB_VINV);
    const float* ssq = (const float*)(P.ws + WS_CTL + CTL_SSQ);
    float* hout = P.out;
    const int tok0 = tile * 32;
    LAS unsigned* elist = (LAS unsigned*)(lds + L_EL); LAS float* glist = (LAS float*)(lds + L_GL);
    LAS unsigned char* idxs = (LAS unsigned char*)(lds + L_IDX) + wid * 1024;
    bf16x8 qfa[2][8];
    {
        const bf16_t* qp = qpeer + (size_t)(tok0 + r32) * DM + wid * 256 + 8 * hi;
#pragma unroll
        for (int p = 0; p < 2; ++p)
#pragma unroll
            for (int s = 0; s < 8; ++s) qfa[p][s] = *(const bf16x8*)(qp + p * 128 + 16 * s);
    }
    __syncthreads();
    if (first) {
        const int q = tid & 7, ln = tid >> 3;
        const f32x4 g2r = *(const f32x4*)(P.norm2_g + 4 * tid), gfr = *(const f32x4*)(P.norm_f_g + 4 * tid);
        u32x4 skr[8];
#pragma unroll
        for (int i = 0; i < 8; ++i) { const int ci = tid + 512 * i; skr[i] = *(const u32x4*)(skb + (size_t)(ci >> 4) * 128 + 8 * (ci & 15)); }
        *(LAS f32x4*)(lds + L_G2 + (q * 64 + ln) * 16) = g2r;
        *(LAS f32x4*)(lds + L_GF + (q * 64 + ln) * 16) = gfr;
#pragma unroll
        for (int i = 0; i < 8; ++i) { const int ci = tid + 512 * i; *(LAS u32x4*)(lds + L_SK + offb(ci >> 4, ci & 15)) = skr[i]; }
        __syncthreads();
    }
    unsigned ta[16], tb[16];
#pragma unroll
    for (int p = 0; p < 2; ++p) {
        f32x16 sc[4];
#pragma unroll
        for (int i = 0; i < 4; ++i)
#pragma unroll
            for (int r = 0; r < 16; ++r) sc[i][r] = 0.f;
        bf16x8 qf[8];
#pragma unroll
        for (int s = 0; s < 8; ++s) qf[s] = qfa[p][s];
#pragma unroll
        for (int kt = 0; kt < 4; ++kt) {
#pragma unroll
            for (int s = 0; s < 8; ++s) {
                const bf16x8 a = *(LAS bf16x8*)(lds + L_SK + offb(p * 128 + 32 * kt + r32, 2 * s + hi));
                sc[kt] = MFMA32(a, qf[s], sc[kt]);
            }
            __builtin_amdgcn_sched_barrier(0);
        }
        unsigned top[16];
        {
            unsigned l1[16], l2[16], l3[16];
#pragma unroll
            for (int r = 0; r < 16; ++r) {
                top[r] = (f2sort(sc[0][r]) & ~127u) | (unsigned)(crow(r, hi));
                l1[r] = (f2sort(sc[1][r]) & ~127u) | (unsigned)(32 + crow(r, hi));
                l2[r] = (f2sort(sc[2][r]) & ~127u) | (unsigned)(64 + crow(r, hi));
                l3[r] = (f2sort(sc[3][r]) & ~127u) | (unsigned)(96 + crow(r, hi));
            }
            bitonic_sort16(top); bitonic_sort16(l1); merge_top16(top, l1);
            bitonic_sort16(l2); bitonic_sort16(l3); merge_top16(l2, l3);
            merge_top16(top, l2);
        }
        unsigned oth[16];
#pragma unroll
        for (int k = 0; k < 16; ++k) oth[k] = (unsigned)__builtin_amdgcn_ds_bpermute((lane ^ 32) << 2, (int)top[k]);
        merge_top16(top, oth);
#pragma unroll
        for (int k = 0; k < 16; ++k) { if (p == 0) ta[k] = top[k]; else tb[k] = top[k]; }
    }
    unsigned ct[16];
    {
        float va[16], vb2[16];
#pragma unroll
        for (int k = 0; k < 16; ++k) { va[k] = sort2f(ta[k] & ~127u); vb2[k] = sort2f(tb[k] & ~127u); }
#define CKEY(i, j) ((f2sort(va[i] + vb2[j]) & ~255u) | (unsigned)(255 - ((i) * 16 + (j))))
#pragma unroll
        for (int j = 0; j < 16; ++j) ct[j] = CKEY(0, j);
        { unsigned r[8]; _Pragma("unroll") for (int j = 0; j < 8; ++j) r[j] = CKEY(1, j); merge_topN<8>(ct, r); }
        { unsigned r[5]; _Pragma("unroll") for (int j = 0; j < 5; ++j) r[j] = CKEY(2, j); merge_topN<5>(ct, r); }
        { unsigned r[4]; _Pragma("unroll") for (int j = 0; j < 4; ++j) r[j] = CKEY(3, j); merge_topN<4>(ct, r); }
        { unsigned r[3]; _Pragma("unroll") for (int j = 0; j < 3; ++j) r[j] = CKEY(4, j); merge_topN<3>(ct, r); }
        { unsigned r[2]; r[0] = CKEY(5, 0); r[1] = CKEY(5, 1); merge_topN<2>(ct, r); }
        { unsigned r[2]; r[0] = CKEY(6, 0); r[1] = CKEY(6, 1); merge_topN<2>(ct, r); }
        { unsigned r[2]; r[0] = CKEY(7, 0); r[1] = CKEY(7, 1); merge_topN<2>(ct, r); }
        { unsigned r[8]; _Pragma("unroll") for (int i = 0; i < 8; ++i) r[i] = CKEY(8 + i, 0); merge_topN<8>(ct, r); }
#undef CKEY
    }
    if (hi == 0) {
#pragma unroll
        for (int k = 0; k < 16; ++k) { idxs[r32 * 32 + k] = (unsigned char)(ta[k] & 127u); idxs[r32 * 32 + 16 + k] = (unsigned char)(tb[k] & 127u); }
    }
    asm volatile("s_waitcnt lgkmcnt(0)" ::: "memory");
    {
        float cs[16]; float mx, sum = 0.f;
#pragma unroll
        for (int k = 0; k < 16; ++k) cs[k] = sort2f(ct[k] & ~255u);
        mx = cs[0];
#pragma unroll
        for (int k = 0; k < 16; ++k) { cs[k] = __expf(cs[k] - mx); sum += cs[k]; }
        const float inv = 1.f / sum;
        unsigned ev[8]; float gvv[8];
#pragma unroll
        for (int k = 0; k < 8; ++k) {
            const unsigned hm = (unsigned)(-hi);
            const unsigned key = (ct[k + 8] & hm) | (ct[k] & ~hm);
            gvv[k] = __builtin_bit_cast(float, (__builtin_bit_cast(unsigned, cs[k + 8]) & hm) | (__builtin_bit_cast(unsigned, cs[k]) & ~hm)) * inv;
            const unsigned cidx = 255u - (key & 255u), ii = cidx >> 4, jj = cidx & 15u;
            ev[k] = (unsigned)idxs[r32 * 32 + ii] * 128u + (unsigned)idxs[r32 * 32 + 16 + jj];
        }
#pragma unroll
        for (int k = 0; k < 8; ++k) {
            const int slot = r32 * 128 + wid * 16 + k + 8 * hi;
            elist[slot] = ev[k]; glist[slot] = gvv[k];
        }
    }
    __syncthreads();
    const rsrc_t rs_o = mk_rsrc(hout + (size_t)tok0 * DM, 32 * DM * 4);
    const rsrc_t rs_hb = mk_rsrc((const bf16_t*)(P.ws + WS_XB) + (size_t)tok0 * DM, 32 * DM * 2);
    const unsigned lv64 = (unsigned)(lane * 64);
    const rsrc_t rs_u = mk_rsrc(ub, 16384 * (DM / 2)), rs_v = mk_rsrc(vb, 16384 * (DM / 2)); const unsigned lv16 = (unsigned)(lane * 16);
    const rsrc_t rs_ui = mk_rsrc(uinv, 16384 * 4), rs_vi = mk_rsrc(vinv, 16384 * 4);
    unsigned eA[PB], eB[PB]; float gA[PB], gB[PB], sA[PB], sB[PB], wA[PB], wB[PB]; u32x4 uA[PB], vA[PB], uB[PB], vB[PB];
    auto issue = [&](unsigned (&e)[PB], float (&gt)[PB], float (&us)[PB], float (&vs)[PB], u32x4 (&uq)[PB], u32x4 (&vq)[PB], int tl_, int k_) {
#pragma unroll
        for (int kk = 0; kk < PB; ++kk) {
            e[kk] = (unsigned)__builtin_amdgcn_readfirstlane((int)elist[tl_ * 128 + k_ + kk]);
            gt[kk] = __builtin_bit_cast(float, __builtin_amdgcn_readfirstlane(__builtin_bit_cast(int, glist[tl_ * 128 + k_ + kk])));
        }
#pragma unroll
        for (int kk = 0; kk < PB; ++kk) {
            us[kk] = __builtin_bit_cast(float, __builtin_amdgcn_raw_buffer_load_b32(rs_ui, 0, (int)(e[kk] * 4u), 0));
            vs[kk] = __builtin_bit_cast(float, __builtin_amdgcn_raw_buffer_load_b32(rs_vi, 0, (int)(e[kk] * 4u), 0));
        }
#pragma unroll
        for (int kk = 0; kk < PB; ++kk) uq[kk] = bld128(rs_u, lv16, e[kk] * (unsigned)(DM / 2));
#pragma unroll
        for (int kk = 0; kk < PB; ++kk) vq[kk] = bld128(rs_v, lv16, e[kk] * (unsigned)(DM / 2));
        __builtin_amdgcn_sched_barrier(0);
    };
    u32x4 hbn[4]; float ssqn = ssq[(size_t)tok0 + 4 * wid];
#pragma unroll
    for (int q4 = 0; q4 < 4; ++q4) hbn[q4] = bld128(rs_hb, (unsigned)(lane * 64 + q4 * 16), (unsigned)(4 * wid * DM * 2));
    issue(eA, gA, sA, wA, uA, vA, 4 * wid, 0);
    for (int tt = 0; tt < 4; ++tt) {
        const int tl = 4 * wid + tt; const size_t row = (size_t)tok0 + tl;
        const unsigned hso = (unsigned)(tl * DM * 4);
        unsigned xb[16]; f32x2_t acc[16];
        u32x4 hbp[4];
        const float rs2 = rsqrtf(ssqn * (1.f / DM) + EPS);
#pragma unroll
        for (int q4 = 0; q4 < 4; ++q4) hbp[q4] = hbn[q4];
        {
            const int ntl = (tt < 3) ? tl + 1 : tl;
            ssqn = ssq[(size_t)tok0 + ntl];
#pragma unroll
            for (int q4 = 0; q4 < 4; ++q4) hbn[q4] = bld128(rs_hb, (unsigned)(lane * 64 + q4 * 16), (unsigned)(ntl * DM * 2));
        }
#pragma unroll
        for (int q4 = 0; q4 < 4; ++q4) {
            const u32x4 hv = hbp[q4];
            const f32x4 ga = *(LAS f32x4*)(lds + L_G2 + ((2 * q4) * 64 + lane) * 16), gb = *(LAS f32x4*)(lds + L_G2 + ((2 * q4 + 1) * 64 + lane) * 16);
            xb[4 * q4] = cvtpk(bflo(hv[0]) * rs2 * ga[0], bfhi(hv[0]) * rs2 * ga[1]); xb[4 * q4 + 1] = cvtpk(bflo(hv[1]) * rs2 * ga[2], bfhi(hv[1]) * rs2 * ga[3]);
            xb[4 * q4 + 2] = cvtpk(bflo(hv[2]) * rs2 * gb[0], bfhi(hv[2]) * rs2 * gb[1]); xb[4 * q4 + 3] = cvtpk(bflo(hv[3]) * rs2 * gb[2], bfhi(hv[3]) * rs2 * gb[3]);
#pragma unroll
            for (int j = 0; j < 4; ++j) acc[4 * q4 + j] = f32x2_t{0.f, 0.f};
        }
#define PEER_U4(W) { d0 = __builtin_amdgcn_fdot2_f32_bf16(__builtin_amdgcn_cvt_scalef32_pk_bf16_fp4(uq[kk][W], 1.0f, 0), __builtin_bit_cast(bf16x2_t, xb[4 * W]), d0, false); \
                     d1 = __builtin_amdgcn_fdot2_f32_bf16(__builtin_amdgcn_cvt_scalef32_pk_bf16_fp4(uq[kk][W], 1.0f, 1), __builtin_bit_cast(bf16x2_t, xb[4 * W + 1]), d1, false); \
                     d0 = __builtin_amdgcn_fdot2_f32_bf16(__builtin_amdgcn_cvt_scalef32_pk_bf16_fp4(uq[kk][W], 1.0f, 2), __builtin_bit_cast(bf16x2_t, xb[4 * W + 2]), d0, false); \
                     d1 = __builtin_amdgcn_fdot2_f32_bf16(__builtin_amdgcn_cvt_scalef32_pk_bf16_fp4(uq[kk][W], 1.0f, 3), __builtin_bit_cast(bf16x2_t, xb[4 * W + 3]), d1, false); }
#define PEER_V4(W) { acc[4 * W] = __builtin_elementwise_fma(h2, __builtin_amdgcn_cvt_scalef32_pk_f32_fp4(vq[kk][W], 1.0f, 0), acc[4 * W]); \
                     acc[4 * W + 1] = __builtin_elementwise_fma(h2, __builtin_amdgcn_cvt_scalef32_pk_f32_fp4(vq[kk][W], 1.0f, 1), acc[4 * W + 1]); \
                     acc[4 * W + 2] = __builtin_elementwise_fma(h2, __builtin_amdgcn_cvt_scalef32_pk_f32_fp4(vq[kk][W], 1.0f, 2), acc[4 * W + 2]); \
                     acc[4 * W + 3] = __builtin_elementwise_fma(h2, __builtin_amdgcn_cvt_scalef32_pk_f32_fp4(vq[kk][W], 1.0f, 3), acc[4 * W + 3]); }
        auto consume = [&](const float (&gt)[PB], const float (&us)[PB], const float (&vs)[PB], u32x4 (&uq)[PB], u32x4 (&vq)[PB]) {
            float dot[PB];
#pragma unroll
            for (int kk = 0; kk < PB; ++kk) {
                float d0 = 0.f, d1 = 0.f;
                if (kk > 0) asm volatile("" : "+v"(uq[kk]), "+v"(dot[kk - 1]));
                PEER_U4(0) PEER_U4(1) PEER_U4(2) PEER_U4(3)
                dot[kk] = d0 + d1;
                __builtin_amdgcn_sched_barrier(0);
            }
#pragma unroll
            for (int kk = 0; kk < PB; ++kk) dot[kk] = wave_sum_u(dot[kk]);
            float hv[PB];
#pragma unroll
            for (int kk = 0; kk < PB; ++kk) hv[kk] = gelu_tanh(dot[kk] * us[kk]) * (gt[kk] * vs[kk]);
            __builtin_amdgcn_sched_barrier(0);
#pragma unroll
            for (int kk = 0; kk < PB; ++kk) {
                asm volatile("" : "+v"(vq[kk]), "+v"(acc[0]), "+v"(acc[15]));
                const f32x2_t h2 = {hv[kk], hv[kk]};
                PEER_V4(0) PEER_V4(1) PEER_V4(2) PEER_V4(3)
                __builtin_amdgcn_sched_barrier(0);
            }
        };
#pragma unroll 1
        for (int k0 = 0; k0 < 128; k0 += 2 * PB) {
            issue(eB, gB, sB, wB, uB, vB, tl, k0 + PB);
            consume(gA, sA, wA, uA, vA);
            {
                int ntl = tl, nk = k0 + 2 * PB;
                if (nk >= 128) { ntl = (tt < 3) ? tl + 1 : tl; nk = 0; }
                issue(eA, gA, sA, wA, uA, vA, ntl, nk);
            }
            consume(gB, sB, wB, uB, vB);
        }
        float ss = 0.f;
#pragma unroll
        for (int q4 = 0; q4 < 4; ++q4) {
            const u32x4 hv = hbp[q4];
#pragma unroll
            for (int j = 0; j < 4; ++j) {
                acc[4 * q4 + j].x += bflo(hv[j]); acc[4 * q4 + j].y += bfhi(hv[j]);
                ss += acc[4 * q4 + j].x * acc[4 * q4 + j].x + acc[4 * q4 + j].y * acc[4 * q4 + j].y;
            }
        }
        ss = wave_sum_u(ss);
        const float rf = rsqrtf(ss * (1.f / DM) + EPS);
        f32x4 gfv[8];
#pragma unroll
        for (int q8 = 0; q8 < 8; ++q8) gfv[q8] = *(LAS f32x4*)(lds + L_GF + (q8 * 64 + lane) * 16);
#pragma unroll
        for (int q8 = 0; q8 < 8; ++q8) {
            const f32x4 gv = gfv[q8];
            gfv[q8] = f32x4{acc[2 * q8].x * rf * gv[0], acc[2 * q8].y * rf * gv[1], acc[2 * q8 + 1].x * rf * gv[2], acc[2 * q8 + 1].y * rf * gv[3]};
        }
        __builtin_amdgcn_sched_barrier(0);
#pragma unroll
        for (int q8 = 0; q8 < 8; ++q8) bstf4(rs_o, (unsigned)(lane * 128 + q8 * 16), hso, gfv[q8]);
        asm volatile("s_nop 7" ::: "memory");
        __builtin_amdgcn_sched_barrier(0);
    }
#pragma unroll
    for (int kk = 0; kk < PB; ++kk) asm volatile("" :: "v"(uA[kk]), "v"(vA[kk]));
#pragma unroll
    for (int q4 = 0; q4 < 4; ++q4) asm volatile("" :: "v"(hbn[q4]));
    asm volatile("" :: "v"(ssqn));
}

typedef __attribute__((address_space(1))) unsigned gu32;
#define XB_TMO      128
#define XB_XCNT(j)  (256  + 64 * (j))
#define XB_XSUB(j)  (1280 + 64 * (j))
#define XB_XGEN(j)  (2304 + 64 * (j))
#define XB_TOP      3328
#define XB_TOPGEN   3392
#define XCD_BAR_WORDS 3456
#define XB_SPIN_CAP (1u << 18)

__device__ __forceinline__ unsigned xb_ld(unsigned* p)              { return __hip_atomic_load(p, __ATOMIC_RELAXED, __HIP_MEMORY_SCOPE_AGENT); }
__device__ __forceinline__ unsigned xb_add(unsigned* p, unsigned v) { return __hip_atomic_fetch_add(p, v, __ATOMIC_RELAXED, __HIP_MEMORY_SCOPE_AGENT); }
__device__ __forceinline__ unsigned xb_xcc_id() { return (unsigned)__builtin_amdgcn_s_getreg((3 << 11) | 20) & 0xFu; }
#define XB_SPIN(cond, bar) do { unsigned _sp = 0; while (cond) { __builtin_amdgcn_s_sleep(1); \
    if ((++_sp & 255u) == 0u) { if (xb_ld(&(bar)[XB_TMO])) break; if (_sp > XB_SPIN_CAP) { atomicAdd(&(bar)[XB_TMO], 1u); break; } } } } while (0)

struct XcdBarrier {
    unsigned* bar; unsigned x;
    volatile LAS unsigned* st;
    int w64;
};

__device__ __forceinline__ XcdBarrier xcd_barrier_post(unsigned* bar, volatile LAS unsigned* st, int w64) {
    XcdBarrier b; b.bar = bar; b.x = xb_xcc_id(); b.st = st; b.w64 = w64;
    if (w64 + lane_now() == 0) (void)xb_add(&bar[XB_XCNT(b.x)], 1u);
    return b;
}
__device__ __forceinline__ void xcd_barrier_complete(unsigned* bar, unsigned x, unsigned& nloc, unsigned& nx) {
    const unsigned G = gridDim.x * gridDim.y * gridDim.z;
    unsigned sum, cnt, mine, sp = 0u;
    for (;;) {
        sum = 0u; cnt = 0u; mine = 0u;
#pragma unroll
        for (unsigned j = 0; j < 16; ++j) { const unsigned c = xb_ld(&bar[XB_XCNT(j)]); sum += c; cnt += (c > 0u) ? 1u : 0u; mine = (j == x) ? c : mine; }
        if (sum == G) break;
        __builtin_amdgcn_s_sleep(1);
        if ((++sp & 255u) == 0u) { if (xb_ld(&bar[XB_TMO])) break; if (sp > XB_SPIN_CAP) { atomicAdd(&bar[XB_TMO], 1u); break; } }
    }
    nloc = mine > 0u ? mine : 1u; nx = cnt > 0u ? cnt : 1u;
}

__device__ __forceinline__ void xcd_barrier(const XcdBarrier& b) {
    asm volatile("s_waitcnt vmcnt(0)" ::: "memory");
    __syncthreads();
    if (b.w64 + lane_now() == 0) {
        unsigned* bar = b.bar;
        __builtin_amdgcn_s_waitcnt(0);
        unsigned nloc = b.st[0], nx = b.st[1];
        if (nloc == 0u) { xcd_barrier_complete(bar, b.x, nloc, nx); b.st[0] = nloc; b.st[1] = nx; }
        const unsigned old = xb_add(&bar[XB_XSUB(b.x)], 1u);
        const unsigned gen = old / nloc;
        if (old + 1u == (gen + 1u) * nloc) {
            __builtin_amdgcn_fence(__ATOMIC_RELEASE, "agent");
            asm volatile("s_waitcnt vmcnt(0)" ::: "memory");
            const unsigned og = xb_add(&bar[XB_TOP], 1u);
            const unsigned tg = og / nx;
            if (og + 1u == (tg + 1u) * nx) xb_add(&bar[XB_TOPGEN], 1u);
            else XB_SPIN(xb_ld(&bar[XB_TOPGEN]) == tg, bar);
            __builtin_amdgcn_fence(__ATOMIC_ACQUIRE, "agent");
            xb_add(&bar[XB_XGEN(b.x)], 1u);
            asm volatile("s_waitcnt vmcnt(0)" ::: "memory");
        } else {
            XB_SPIN(xb_ld(&bar[XB_XGEN(b.x)]) == gen, bar);
            __builtin_amdgcn_fence(__ATOMIC_ACQUIRE, "agent");
            asm volatile("s_waitcnt vmcnt(0)" ::: "memory");
        }
    }
    __syncthreads();
}
struct Args { Ptrs p; int ph_lo, ph_hi; };
constexpr int NPHASE = 7;

__global__ void __launch_bounds__(NTHREADS, 2) mega(Args args) {
    extern __shared__ __attribute__((aligned(16))) unsigned char lds_raw[];
    ldsb* lds = (ldsb*)lds_raw;
    const Ptrs P = args.p;
    const int wv64 = __builtin_amdgcn_readfirstlane((int)threadIdx.x) & ~63;
#define TIDNOW() (wv64 + lane_now())
    const int G = gridDim.x, bx = blockIdx.x;
    unsigned char* ws = P.ws;
    cg::grid_group grid = cg::this_grid();
    if (args.ph_hi > 1000) grid.sync();
    const int lo = args.ph_lo, hi = args.ph_hi;
    volatile LAS unsigned* bst = (volatile LAS unsigned*)(lds + LDS_BYTES - 64);
    { const int t0 = TIDNOW(); if (t0 < 2) bst[t0] = 0u; }
    __syncthreads();
    XcdBarrier bar = xcd_barrier_post((unsigned*)(ws + WS_CTL + 16384), bst, wv64);
#ifdef ONLY_PHASE
#define IN(k) ((k) == ONLY_PHASE && lo <= (k) && (k) < hi)
#else
#define IN(k) (lo <= (k) && (k) < hi)
#endif
#define SEAM(k) do { if (IN(k) && IN((k) + 1)) xcd_barrier(bar); } while (0)
    if (IN(0)) { phase0(P, lds, TIDNOW(), G); }
    SEAM(0);
    if (IN(1)) {
        pg8::Gemm g{(const bf16_t*)(ws + WS_XB), (const bf16_t*)(ws + WS_WIN), MTOK, NPAD, DM};
        pg8::StaticOrder S; S.init(MTOK, NPAD, G, bx);
        pg8::EpiProj E{(bf16_t*)(ws + WS_PROJ), NPAD, (const float*)(ws + WS_TAB + TAB_RS1), (const float*)(ws + WS_TAB + TAB_COS), (const float*)(ws + WS_TAB + TAB_SIN)};
        pg8::gemm_phase<pg8::EpiProj, pg8::StaticOrder, true, true>(lds, g, S, E, TIDNOW());
        if (G == 256 && bx >= 192) {
            const int tv = TIDNOW();
            convert_table_rows(P, 0, (bx - 192) * NWAVES + (tv >> 6), 64 * NWAVES, tv & 63);
        }
    }
    SEAM(1);
    if (IN(2)) {
        for (int it = bx; it < 256; it += G) { const int tv = TIDNOW(); compress_step1(lds, P, it >> 7, (it >> 3) & 15, it & 7, tv); }
        { const int tv = TIDNOW(); retention_state_units(lds, P, bx, G, tv); }
    }
    SEAM(2);
    if (IN(3)) {
        for (int it = bx; it < 128; it += G) { const int tv = TIDNOW(); compress_step2(lds, P, it >> 6, (it >> 2) & 15, it & 3, tv); }
        {
            const int u0 = (G > 128) ? bx - 128 : bx, us = (G > 128) ? G - 128 : G;
            if (u0 >= 0) for (int u = u0; u < 128; u += us) { const int tv = TIDNOW(); retention_scan_unit(P, u, tv); }
            if (G == 256) { const int tv = TIDNOW(); const int VS = 11264;
                if (bx >= 128) convert_table_rows(P, 1, (bx - 128) * NWAVES + (tv >> 6), 128 * NWAVES, tv & 63, VS);
                else convert_table_rows(P, 1, VS + bx * NWAVES + (tv >> 6), 128 * NWAVES, tv & 63, MTOK); }
        }
        xcd_barrier(bar);
    }
    if (IN(3)) {
        for (int it = bx, rd = 0; it < 512; it += G, ++rd) {
            const int bg = it & 15, q = (it >> 4);
            const int qi = (q < 16) ? 31 - q : q - 16;
            const int tv = TIDNOW();
            nsa_unit(lds, P, bg >> 1, bg & 1, qi, tv);
        }
        for (int it = bx; it < 512; it += G) {
            const int tv = TIDNOW();
            const int bh = it & 63, j4 = (it >> 6) & 3, jp = (it >> 8) ? 7 - j4 : j4;
            retention_out_unit(lds, P, bh >> 3, bh & 7, jp, tv);
        }
    }
    SEAM(3);
    if (IN(4)) {
        pg8::Gemm g{(const bf16_t*)(ws + WS_MIX), (const bf16_t*)(ws + WS_WOUT), MTOK, DM, DM};
        pg8::StaticOrder S; S.init(MTOK, DM, G, bx);
        pg8::EpiResidual E{(const bf16_t*)(ws + WS_XB), P.out, (bf16_t*)(ws + WS_XB), (float*)(ws + WS_CTL + CTL_SSQ), DM};
        pg8::gemm_phase<pg8::EpiResidual, pg8::StaticOrder, true, true>(lds, g, S, E, TIDNOW());
    }
    SEAM(4);
    if (IN(5)) {
        pg8::Gemm g{(const bf16_t*)(ws + WS_XB), (const bf16_t*)(ws + WS_WQ), MTOK, DM, DM};
        pg8::StaticOrder S; S.init(MTOK, DM, G, bx);
        pg8::EpiRowScaleBf16 E{(bf16_t*)(ws + WS_PROJ), DM, (const float*)(ws + WS_CTL + CTL_SSQ), 1};
        pg8::gemm_phase<pg8::EpiRowScaleBf16, pg8::StaticOrder, true, true>(lds, g, S, E, TIDNOW());
    }
    SEAM(5);
    if (IN(6)) {
        for (int it = bx; it < MTOK / 32; it += G) { const int tv = TIDNOW(); peer_tile(lds, P, it, tv, it == bx); }
    }
#undef IN
#undef SEAM
}

extern "C" void kernel_launch(void* const* d_in, const int* in_sizes, int n_in, void* d_out, int out_size, void* d_ws, size_t ws_size, hipStream_t stream) {
    static int grid = 0;
    if (grid == 0) {
        if (n_in != 16 || out_size != MTOK * DM || ws_size < WS_END) { fprintf(stderr, "kernel_launch: unexpected shapes (n_in %d out %d ws %zu)\n", n_in, out_size, ws_size); grid = -1; return; }
        int dev = 0, cus = 0, per_cu = 0;
        hipGetDevice(&dev); hipDeviceGetAttribute(&cus, hipDeviceAttributeMultiprocessorCount, dev);
        if (hipFuncSetAttribute((const void*)mega, hipFuncAttributeMaxDynamicSharedMemorySize, LDS_BYTES) != hipSuccess) { fprintf(stderr, "kernel_launch: hipFuncSetAttribute failed\n"); grid = -1; return; }
        hipOccupancyMaxActiveBlocksPerMultiprocessor(&per_cu, (const void*)mega, NTHREADS, LDS_BYTES);
        if (per_cu < 1) { fprintf(stderr, "kernel_launch: occupancy query says %d\n", per_cu); per_cu = 1; }
        (void)hipGetLastError();
        grid = cus;
    }
    if (grid < 0) return;
    hipMemsetAsync((char*)d_ws + WS_CTL, 0, CTL_BYTES, stream);
    Args a{};
    const float** pp = (const float**)&a.p;
    for (int i = 0; i < 16; ++i) pp[i] = (const float*)d_in[i];
    a.p.out = (float*)d_out; a.p.ws = (unsigned char*)d_ws;
#if N_LAUNCHES == 1
    a.ph_lo = 0; a.ph_hi = NPHASE;
    void* kargs[] = {&a};
    hipError_t e = hipLaunchCooperativeKernel((const void*)mega, dim3(grid), dim3(NTHREADS), kargs, LDS_BYTES, stream);
    if (e != hipSuccess) fprintf(stderr, "cooperative launch failed: %s (grid %d)\n", hipGetErrorString(e), grid);
#else
    for (int ph = 0; ph < NPHASE; ++ph) {
        a.ph_lo = ph; a.ph_hi = ph + 1;
        hipLaunchKernelGGL(mega, dim3(grid), dim3(NTHREADS), LDS_BYTES, stream, a);
    }
#endif
}
```

```cpp
#include <hip/hip_runtime.h>
#include <hip/hip_cooperative_groups.h>
#include <cstdio>
#include <cstdint>
namespace cg = cooperative_groups;
#ifndef PB
#define PB 4
#endif
#ifndef N_LAUNCHES
#define N_LAUNCHES 1
#endif
__device__ __forceinline__ int lane_now() { int ln; asm volatile("v_mbcnt_lo_u32_b32 %0, -1, 0\n\tv_mbcnt_hi_u32_b32 %0, -1, %0" : "=v"(ln)); return ln; }
namespace pg8 {
#define PG8_LAS __attribute__((address_space(3)))
typedef unsigned short bf16_t;
typedef short bf16x8 __attribute__((ext_vector_type(8)));
typedef float f32x4 __attribute__((ext_vector_type(4)));
typedef unsigned u32x4 __attribute__((ext_vector_type(4)));
constexpr int BM = 256, BK = 64, HALF = 128, HTB = HALF * BK * 2  , STAGE_BYTES = 8 * HTB, NXCD = 8, WGM = 8;

__host__ __device__ __forceinline__ int lds_byte(int r, int c) { const int st = (r >> 4) * 2 + (c >> 5), rr = r & 15, cc = c & 31, ob = rr * 64 + cc * 2; return st * 1024 + (ob ^ (((ob >> 9) & 1) << 5)); }
__host__ __device__ __forceinline__ void stage_rc(int b, int& R, int& C) { const int st = b / 1024, sb = b % 1024, swz = sb ^ (((sb >> 9) & 1) << 5); R = (st >> 1) * 16 + swz / 64; C = (st & 1) * 32 + (swz % 64) / 2; }
__host__ __device__ __forceinline__ int perm32(int rho) { const int n = rho >> 4, i = rho & 15; return 8 * (i >> 2) + 4 * n + (i & 3); }

struct Unit { int pm, pn; };
struct Gemm { const bf16_t* A; const bf16_t* Bt; int M, N, K; };

struct StaticOrder {
    int nM, nN, nwg, G, c;
    __host__ __device__ void init(int M, int N, int G_, int c_) { nM = M / BM; nN = N / BM; nwg = nM * nN; G = G_; c = c_; }
    __host__ __device__ bool next(int i, Unit& u) const {
        const long L = (long)i * G + c; if (L >= nwg) return false;
        int wgid = (int)L; { const int q = nwg / NXCD, r = nwg % NXCD, xcd = wgid % NXCD, off = wgid / NXCD; wgid = (xcd < r ? xcd * (q + 1) : r * (q + 1) + (xcd - r) * q) + off; }
        const int nig = WGM * nN, gid = wgid / nig, fm = gid * WGM, gsz = (nM - fm) < WGM ? (nM - fm) : WGM;
        u.pm = fm + ((wgid % nig) % gsz); u.pn = (wgid % nig) / gsz; return true;
    }
    __device__ __forceinline__ void a_ready(const Unit&) const {}
    __device__ __forceinline__ void done(const Unit&) const {}
};

__device__ __forceinline__ unsigned cvt_pk_bf16(float lo, float hi) { unsigned r; asm volatile("v_cvt_pk_bf16_f32 %0, %1, %2" : "=v"(r) : "v"(lo), "v"(hi)); return r; }
typedef float f32x2 __attribute__((ext_vector_type(2)));
template <class Epi, class Sched, bool ALIGN_EPI = false, bool SP2 = false>
__device__ __forceinline__ void gemm_phase(PG8_LAS unsigned char* lds, const Gemm g, const Sched& S, const Epi& E, const int tid_in) {
    const int tid = tid_in, wid = __builtin_amdgcn_readfirstlane(tid >> 6), lane = tid & 63, wr = wid >> 2, wc = wid & 3, fr = lane & 15, fq = lane >> 4;
    const int K = g.K, nt = K / BK;
    unsigned voffA[2], voffB[2];
#pragma unroll
    for (int i = 0; i < 2; ++i) { int R, C; stage_rc(tid * 16 + i * 8192, R, C); const int Rb = Epi::PERM ? ((R & ~31) + perm32(R & 31)) : R;
        voffA[i] = (unsigned)(R * K + C) * 2u; voffB[i] = (unsigned)(Rb * K + C) * 2u; }
    const size_t kstep = (size_t)(BK * 2);
    const size_t hstep = (size_t)HALF * K * 2;
    const size_t tstep = 2 * hstep;
    const unsigned ldsw = (unsigned)wid * 1024u;
    const int aoff = lds_byte(wr * 64 + fr, fq * 8), boff = lds_byte(wc * 32 + fr, fq * 8);
#define PG8_SA(b, h) (((b) * 2 + (h)) * HTB)
#define PG8_SB(b, h) ((4 + (b) * 2 + (h)) * HTB)
#define PG8_STAGE(bufoff, gbase, voff) do { _Pragma("unroll") for (int _i = 0; _i < 2; ++_i) \
        __builtin_amdgcn_global_load_lds((const unsigned*)((const char*)(gbase) + (voff)[_i]), (PG8_LAS unsigned*)(lds + (bufoff) + ldsw + _i * 8192), 16, 0, 0); } while (0)
#define PG8_LDA(dst, b, h) do { _Pragma("unroll") for (int m = 0; m < 4; ++m) _Pragma("unroll") for (int k = 0; k < 2; ++k) dst[m][k] = *(const PG8_LAS bf16x8*)(lds + PG8_SA(b, h) + aoff + m * 2048 + k * 1024); } while (0)
#define PG8_LDB(dst, b, h) do { _Pragma("unroll") for (int n = 0; n < 2; ++n) _Pragma("unroll") for (int k = 0; k < 2; ++k) dst[n][k] = *(const PG8_LAS bf16x8*)(lds + PG8_SB(b, h) + boff + n * 2048 + k * 1024); } while (0)
#define PG8_MMA(ai, bj, At, Bt) do { __builtin_amdgcn_s_setprio(1); _Pragma("unroll") for (int m = 0; m < 4; ++m) _Pragma("unroll") for (int n = 0; n < 2; ++n) _Pragma("unroll") for (int k = 0; k < 2; ++k) \
        acc[ai][bj][m][n] = __builtin_amdgcn_mfma_f32_16x16x32_bf16(Bt[n][k], At[m][k], acc[ai][bj][m][n], 0, 0, 0); __builtin_amdgcn_s_setprio(0); } while (0)
#define PG8_WAIT_V(n) asm volatile("s_waitcnt vmcnt(" #n ")" ::: "memory")
#define PG8_WAIT_L(n) asm volatile("s_waitcnt lgkmcnt(" #n ")" ::: "memory")
#define PG8_BAR __builtin_amdgcn_s_barrier()
#define PG8_SCHED __builtin_amdgcn_sched_barrier(0)
    Unit cur, nxt; int ui = 0;
    if (!S.next(0, cur)) return;
    f32x4 acc[2][2][4][2];
#pragma unroll
    for (int a = 0; a < 2; ++a)
#pragma unroll
        for (int b = 0; b < 2; ++b)
#pragma unroll
            for (int m = 0; m < 4; ++m)
#pragma unroll
                for (int n = 0; n < 2; ++n) acc[a][b][m][n] = (f32x4){0.f, 0.f, 0.f, 0.f};
    bf16x8 At[4][2], B0[2][2], B1[2][2];
    const char* cA = (const char*)g.A + (size_t)cur.pm * tstep; const char* cB = (const char*)g.Bt + (size_t)cur.pn * tstep;
    S.a_ready(cur);
    if constexpr (SP2) {
        PG8_STAGE(PG8_SB(0, 0), cB, voffB); PG8_STAGE(PG8_SB(0, 1), cB + hstep, voffB); PG8_STAGE(PG8_SA(0, 0), cA, voffA); PG8_STAGE(PG8_SA(0, 1), cA + hstep, voffA);
        if (wr == 1) PG8_BAR;
        PG8_WAIT_V(2); PG8_BAR;
        PG8_STAGE(PG8_SB(1, 0), cB + kstep, voffB); PG8_STAGE(PG8_SA(1, 0), cA + kstep, voffA); PG8_STAGE(PG8_SB(1, 1), cB + hstep + kstep, voffB);
        PG8_WAIT_V(6); PG8_BAR;
    } else {
        PG8_STAGE(PG8_SB(0, 0), cB, voffB); PG8_STAGE(PG8_SA(0, 0), cA, voffA); PG8_STAGE(PG8_SB(0, 1), cB + hstep, voffB); PG8_STAGE(PG8_SA(0, 1), cA + hstep, voffA);
        if (wr == 1) PG8_BAR;
        PG8_WAIT_V(4); PG8_BAR;
        PG8_STAGE(PG8_SB(1, 0), cB + kstep, voffB); PG8_STAGE(PG8_SA(1, 0), cA + kstep, voffA); PG8_STAGE(PG8_SB(1, 1), cB + hstep + kstep, voffB);
        PG8_WAIT_V(6); PG8_BAR;
    }
    for (;;) {
        const bool has_next = S.next(ui + 1, nxt);
        const char* nA = has_next ? (const char*)g.A + (size_t)nxt.pm * tstep : cA; const char* nB = has_next ? (const char*)g.Bt + (size_t)nxt.pn * tstep : cB;
        for (int t = 0; t < nt; t += 2) {
            const bool last = (t == nt - 2);
            const char* a1 = cA + (size_t)(t + 1) * kstep;
            const char* a2 = last ? nA : cA + (size_t)(t + 2) * kstep; const char* b2 = last ? nB : cB + (size_t)(t + 2) * kstep;
            const char* a3 = a2 + kstep; const char* b3 = b2 + kstep;
            if (last && has_next) S.a_ready(nxt);
            if constexpr (SP2) {
            PG8_LDB(B0, 0, 0); PG8_LDB(B1, 0, 1); PG8_SCHED; PG8_LDA(At, 0, 0); PG8_STAGE(PG8_SA(1, 1), a1 + hstep, voffA);
            PG8_WAIT_V(8); PG8_WAIT_L(0); PG8_BAR; PG8_MMA(0, 0, At, B0); PG8_MMA(0, 1, At, B1); PG8_BAR; PG8_SCHED;
            PG8_LDA(At, 0, 1); PG8_STAGE(PG8_SB(0, 0), b2, voffB); PG8_STAGE(PG8_SB(0, 1), b2 + hstep, voffB); PG8_STAGE(PG8_SA(0, 0), a2, voffA);
            PG8_WAIT_V(8); PG8_WAIT_L(0); PG8_BAR; PG8_MMA(1, 0, At, B0); PG8_MMA(1, 1, At, B1); PG8_BAR; PG8_SCHED;
            PG8_LDB(B0, 1, 0); PG8_LDB(B1, 1, 1); PG8_SCHED; PG8_LDA(At, 1, 0); PG8_STAGE(PG8_SA(0, 1), a2 + hstep, voffA);
            PG8_WAIT_V(8); PG8_WAIT_L(0); PG8_BAR; PG8_MMA(0, 0, At, B0); PG8_MMA(0, 1, At, B1); PG8_BAR; PG8_SCHED;
            PG8_LDA(At, 1, 1); PG8_STAGE(PG8_SB(1, 0), b3, voffB); PG8_STAGE(PG8_SB(1, 1), b3 + hstep, voffB); PG8_STAGE(PG8_SA(1, 0), a3, voffA);
            PG8_WAIT_V(8); PG8_WAIT_L(0); PG8_BAR; PG8_MMA(1, 0, At, B0); PG8_MMA(1, 1, At, B1); PG8_BAR; PG8_SCHED;
            } else {
            PG8_LDB(B0, 0, 0); PG8_SCHED; PG8_LDA(At, 0, 0); PG8_STAGE(PG8_SA(1, 1), a1 + hstep, voffA);
            PG8_WAIT_L(8); PG8_BAR; PG8_WAIT_L(0); PG8_MMA(0, 0, At, B0); PG8_BAR; PG8_SCHED;
            PG8_LDB(B1, 0, 1); PG8_STAGE(PG8_SB(0, 0), b2, voffB);
            PG8_BAR; PG8_WAIT_L(0); PG8_MMA(0, 1, At, B1); PG8_BAR;
            PG8_LDA(At, 0, 1); PG8_STAGE(PG8_SA(0, 0), a2, voffA);
            PG8_BAR; PG8_WAIT_L(0); PG8_MMA(1, 0, At, B0); PG8_BAR; PG8_SCHED;
            PG8_STAGE(PG8_SB(0, 1), b2 + hstep, voffB);
            PG8_WAIT_V(6); PG8_BAR; PG8_MMA(1, 1, At, B1); PG8_BAR;
            PG8_LDB(B0, 1, 0); PG8_SCHED; PG8_LDA(At, 1, 0); PG8_STAGE(PG8_SA(0, 1), a2 + hstep, voffA);
            PG8_WAIT_L(8); PG8_BAR; PG8_WAIT_L(0); PG8_MMA(0, 0, At, B0); PG8_BAR; PG8_SCHED;
            PG8_LDB(B1, 1, 1); PG8_STAGE(PG8_SB(1, 0), b3, voffB);
            PG8_BAR; PG8_WAIT_L(0); PG8_MMA(0, 1, At, B1); PG8_BAR;
            PG8_LDA(At, 1, 1); PG8_STAGE(PG8_SA(1, 0), a3, voffA);
            PG8_BAR; PG8_WAIT_L(0); PG8_MMA(1, 0, At, B0); PG8_BAR; PG8_SCHED;
            PG8_STAGE(PG8_SB(1, 1), b3 + hstep, voffB);
            PG8_WAIT_V(6); PG8_BAR; PG8_MMA(1, 1, At, B1); PG8_BAR;
            }
        }
        if constexpr (ALIGN_EPI) { if (wr == 0) PG8_BAR; }
        if constexpr (!Epi::AFTER_DRAIN) { E(acc, cur, wr, wc, fr, fq); S.done(cur); }
        if (!has_next) break;
#pragma unroll
        for (int a = 0; a < 2; ++a)
#pragma unroll
            for (int b = 0; b < 2; ++b)
#pragma unroll
                for (int m = 0; m < 4; ++m)
#pragma unroll
                    for (int n = 0; n < 2; ++n) acc[a][b][m][n] = (f32x4){0.f, 0.f, 0.f, 0.f};
        cur = nxt; cA = nA; cB = nB; ++ui;
        if constexpr (ALIGN_EPI) { if (wr == 1) PG8_BAR; }
    }
    PG8_WAIT_V(0);
    if constexpr (!ALIGN_EPI) { if (wr == 0) PG8_BAR; }
    PG8_BAR;
    if constexpr (Epi::AFTER_DRAIN) { E.fused(acc, cur, wr, wc, fr, fq, lds, wid, lane); S.done(cur); }
#undef PG8_SA
#undef PG8_SB
#undef PG8_STAGE
#undef PG8_LDA
#undef PG8_LDB
#undef PG8_MMA
#undef PG8_WAIT_V
#undef PG8_WAIT_L
#undef PG8_BAR
#undef PG8_SCHED
}
}
#define DI __device__ __forceinline__
#define LAS __attribute__((address_space(3)))
typedef unsigned short bf16_t;
typedef short bf16x8 __attribute__((ext_vector_type(8)));
typedef short s16x4 __attribute__((ext_vector_type(4)));
typedef float f32x4 __attribute__((ext_vector_type(4)));
typedef float f32x16 __attribute__((ext_vector_type(16)));
typedef unsigned u32x4 __attribute__((ext_vector_type(4)));
typedef unsigned u32x2 __attribute__((ext_vector_type(2)));
typedef float f32x2_t __attribute__((ext_vector_type(2)));
typedef __bf16 bf16x2_t __attribute__((ext_vector_type(2)));
typedef LAS unsigned char ldsb;

constexpr int DM = 2048, NB = 8, SEQ = 2048, MTOK = NB * SEQ;
constexpr int IN_COLS = 5656, NPAD = 5888;
constexpr int C_RQ = 0, C_RK = 512, C_RV = 1024, C_RG = 2048, C_NQ = 3072, C_KV = 4096, C_GATE = 5632;
constexpr float EPS = 1e-6f;
constexpr int NTHREADS = 512, NWAVES = 8;

constexpr size_t MiB = 1u << 20;
constexpr size_t WS_CTL = 0, CTL_BYTES = 1 * MiB;
constexpr size_t CTL_SSQ = 256 * 1024;
constexpr size_t CTL_QUEUE = 128 * 1024;
constexpr size_t WS_CBP = 486 * MiB;
constexpr size_t WS_WIN = 1 * MiB;
constexpr size_t WS_WOUT = 24 * MiB;
constexpr size_t WS_WQ = 32 * MiB;
constexpr size_t WS_TAB = 40 * MiB;
constexpr size_t TAB_COS = 0, TAB_SIN = 256 * 1024, TAB_LUT = 512 * 1024, TAB_RS1 = 576 * 1024, TAB_SK = 640 * 1024, TAB_W2T = 704 * 1024, TAB_UINV = 832 * 1024, TAB_VINV = 896 * 1024;
constexpr size_t WS_W1T = 41 * MiB;
constexpr size_t WS_KCMP = 45 * MiB;
constexpr size_t WS_VCMP = 45 * MiB + 512 * 1024;
constexpr size_t WS_XB = 46 * MiB;
constexpr size_t WS_PROJ = 110 * MiB;
constexpr size_t WS_MIX = 294 * MiB;
constexpr size_t WS_UB = 358 * MiB;
constexpr size_t WS_VB = 422 * MiB;
constexpr size_t WS_CPART0 = 406 * MiB, WS_CPART1 = 470 * MiB;
constexpr size_t WS_NSCR0 = 374 * MiB, WS_NSCR1 = 438 * MiB;
constexpr size_t WS_KVT = 488 * MiB;
constexpr size_t WS_END = 505 * MiB;

constexpr int LDS_BYTES = 147456 + 64;
constexpr int L_K = 0, L_V = 16384, L_WSF = 32768, L_LUT = 36864, L_MISC = 40960, L_Q = 49152, L_K2 = 114688, L_V2 = 131072;
constexpr int L_HID = 0;
constexpr int L_EL = 0, L_GL = 16384, L_UL = 32768, L_IDX = 49152, L_G2 = 57344, L_GF = 65536, L_SK = 73728;

DI unsigned f2bf(float f) { unsigned u = __builtin_bit_cast(unsigned, f); return (u + 0x7fffu + ((u >> 16) & 1u)) >> 16; }
DI unsigned pk2(float lo, float hi) { return f2bf(lo) | (f2bf(hi) << 16); }
DI unsigned cvtpk(float lo, float hi) { f32x2_t v = {lo, hi}; bf16x2_t b = __builtin_convertvector(v, bf16x2_t); return __builtin_bit_cast(unsigned, b); }
DI float dot2bf(unsigned a, unsigned b, float c) { return __builtin_amdgcn_fdot2_f32_bf16(__builtin_bit_cast(bf16x2_t, a), __builtin_bit_cast(bf16x2_t, b), c, false); }
DI float bflo(unsigned u) { return __builtin_bit_cast(float, u << 16); }
DI float bfhi(unsigned u) { return __builtin_bit_cast(float, u & 0xffff0000u); }
DI float bf2f(bf16_t h) { return __builtin_bit_cast(float, (unsigned)h << 16); }
DI float wave_sum(float v) {
#pragma unroll
    for (int o = 1; o < 64; o <<= 1) v += __shfl_xor(v, o);
    return v;
}
template <int CTRL, int ROWMASK> DI float dpp_add(float v) {
    const int t = __builtin_amdgcn_update_dpp(0, __builtin_bit_cast(int, v), CTRL, ROWMASK, 0xf, true);
    return v + __builtin_bit_cast(float, t);
}
DI float wave_sum_u(float v) {
    v = dpp_add<0x111, 0xf>(v);
    v = dpp_add<0x112, 0xf>(v);
    v = dpp_add<0x114, 0xf>(v);
    v = dpp_add<0x118, 0xf>(v);
    v = dpp_add<0x142, 0xa>(v);
    v = dpp_add<0x143, 0xc>(v);
    return __builtin_bit_cast(float, __builtin_amdgcn_readlane(__builtin_bit_cast(int, v), 63));
}
DI float half_sum(float v) {
#pragma unroll
    for (int o = 1; o < 32; o <<= 1) v += __shfl_xor(v, o);
    return v;
}
typedef __amdgpu_buffer_rsrc_t rsrc_t;
DI rsrc_t mk_rsrc(const void* p, unsigned bytes) { return __builtin_amdgcn_make_buffer_rsrc((void*)p, (short)0, (int)bytes, 0x00020000); }
DI u32x4 bld128(rsrc_t r, unsigned voff, unsigned soff) { return __builtin_amdgcn_raw_buffer_load_b128(r, (int)voff, (int)soff, 0); }
DI f32x4 bldf4(rsrc_t r, unsigned voff, unsigned soff) { return __builtin_bit_cast(f32x4, __builtin_amdgcn_raw_buffer_load_b128(r, (int)voff, (int)soff, 0)); }
DI void bstf4(rsrc_t r, unsigned voff, unsigned soff, f32x4 v) { __builtin_amdgcn_raw_buffer_store_b128(__builtin_bit_cast(u32x4, v), r, (int)voff, (int)soff, 16); }
DI void bst128_wt(rsrc_t r, unsigned voff, u32x4 v) { __builtin_amdgcn_raw_buffer_store_b128(v, r, (int)voff, 0, 16); }
DI int crow(int r, int hi) { return (r & 3) + 8 * (r >> 2) + 4 * hi; }
DI unsigned offb(unsigned row, unsigned ch) { return 256u * row + 16u * (ch ^ (((row & 3u) << 2) | ((row >> 2) & 3u))); }
DI unsigned offk64(unsigned row, unsigned ch) { return 128u * row + 16u * (ch ^ (row & 7u)); }
#define MFMA32(a, b, c) __builtin_amdgcn_mfma_f32_32x32x16_bf16((a), (b), (c), 0, 0, 0)
DI bf16x8 packf(const f32x16& x, int s) {
    u32x4 p = {cvtpk(x[8 * s], x[8 * s + 1]), cvtpk(x[8 * s + 2], x[8 * s + 3]), cvtpk(x[8 * s + 4], x[8 * s + 5]), cvtpk(x[8 * s + 6], x[8 * s + 7])};
    return __builtin_bit_cast(bf16x8, p);
}
DI float gelu_tanh(float x) {
    const float z = 0.7978845608028654f * (x + 0.044715f * x * x * x);
    const float e = __expf(2.f * z);
    const float th = 1.f - 2.f * __builtin_amdgcn_rcpf(e + 1.f);
    return 0.5f * x * (1.f + th);
}
typedef short v4i16_t __attribute__((ext_vector_type(4)));
DI s16x4 vtr(ldsb* p) { return __builtin_bit_cast(s16x4, __builtin_amdgcn_ds_read_tr16_b64_v4i16((LAS v4i16_t*)p)); }

DI void qk128(f32x16& p0, f32x16& p1, ldsb* Kl, const bf16x8 (&qf)[8], int r32, int hi) {
#pragma unroll
    for (int s = 0; s < 8; ++s) {
        const bf16x8 a0 = *(LAS bf16x8*)(Kl + offb(r32, 2 * s + hi));
        const bf16x8 a1 = *(LAS bf16x8*)(Kl + offb(32 + r32, 2 * s + hi));
        p0 = MFMA32(a0, qf[s], p0); p1 = MFMA32(a1, qf[s], p1);
    }
}
DI void qk128l(f32x16& p0, f32x16& p1, ldsb* Kl, ldsb* Ql, int lane, int r32, int hi) {
#pragma unroll
    for (int s = 0; s < 8; ++s) {
        const bf16x8 qv = *(LAS bf16x8*)(Ql + (s * 64 + lane) * 16);
        const bf16x8 a0 = *(LAS bf16x8*)(Kl + offb(r32, 2 * s + hi));
        const bf16x8 a1 = *(LAS bf16x8*)(Kl + offb(32 + r32, 2 * s + hi));
        p0 = MFMA32(a0, qv, p0); p1 = MFMA32(a1, qv, p1);
    }
}
DI void qk64(f32x16& p0, f32x16& p1, ldsb* Kl, const bf16x8 (&qf)[4], int r32, int hi) {
#pragma unroll
    for (int s = 0; s < 4; ++s) {
        const bf16x8 a0 = *(LAS bf16x8*)(Kl + offk64(r32, 2 * s + hi));
        const bf16x8 a1 = *(LAS bf16x8*)(Kl + offk64(32 + r32, 2 * s + hi));
        p0 = MFMA32(a0, qf[s], p0); p1 = MFMA32(a1, qf[s], p1);
    }
}
DI void pv128(f32x16 (&o)[4], const f32x16& p0, const f32x16& p1, ldsb* Vl, int lane) {
    const bf16x8 pa[4] = {packf(p0, 0), packf(p0, 1), packf(p1, 0), packf(p1, 1)};
    const unsigned h = lane >> 5, blk = (lane >> 4) & 1, q = (lane & 15) >> 2, p = lane & 3;
#pragma unroll
    for (int c = 0; c < 4; ++c)
#pragma unroll
        for (int s = 0; s < 4; ++s) {
            const unsigned ch = 4 * c + 2 * blk + (p >> 1);
            const s16x4 lo = vtr(Vl + offb(16 * s + 4 * h + q, ch) + 8 * (p & 1));
            const s16x4 hi_ = vtr(Vl + offb(16 * s + 8 + 4 * h + q, ch) + 8 * (p & 1));
            const bf16x8 bfrag = {lo[0], lo[1], lo[2], lo[3], hi_[0], hi_[1], hi_[2], hi_[3]};
            o[c] = MFMA32(pa[s], bfrag, o[c]);
            if (s == 3) __builtin_amdgcn_sched_barrier(0);
        }
}
DI void stage128(ldsb* dst, const bf16_t* src, size_t pitch, int tid) {
    const int row = tid >> 4, ch = tid & 15;
    const u32x4 v0 = *(const u32x4*)(src + (size_t)row * pitch + 8 * ch), v1 = *(const u32x4*)(src + (size_t)(row + 32) * pitch + 8 * ch);
    *(LAS u32x4*)(dst + offb(row, ch)) = v0; *(LAS u32x4*)(dst + offb(row + 32, ch)) = v1;
}
DI void stage128x2(ldsb* dk, const bf16_t* sk, ldsb* dv, const bf16_t* sv, size_t pitch, int tid) {
    const int row = tid >> 4, ch = tid & 15;
    const u32x4 k0 = *(const u32x4*)(sk + (size_t)row * pitch + 8 * ch), k1 = *(const u32x4*)(sk + (size_t)(row + 32) * pitch + 8 * ch);
    const u32x4 v0 = *(const u32x4*)(sv + (size_t)row * pitch + 8 * ch), v1 = *(const u32x4*)(sv + (size_t)(row + 32) * pitch + 8 * ch);
    *(LAS u32x4*)(dk + offb(row, ch)) = k0; *(LAS u32x4*)(dk + offb(row + 32, ch)) = k1;
    *(LAS u32x4*)(dv + offb(row, ch)) = v0; *(LAS u32x4*)(dv + offb(row + 32, ch)) = v1;
}

DI void p0_transpose_item(const float* W, int K, int N, bf16_t* WT, LAS float* scr, int item, int nblk, int lane, const float* kscale, int csmode) {
    const int kb = item / nblk, nb = item % nblk, k0 = 64 * kb, n0 = 32 * nb;
    const int n = n0 + (lane & 31);
    float cs = 1.f;
    int nsrc = n;
    if (csmode == 1) {
        if (n < 512) cs = 0.125f; else if (n >= C_NQ && n < C_KV) cs = 0.08838834764831845f * 1.4426950408889634f;
        if (n < 1024) { const int p = n & 63; nsrc = (n & ~63) + (p >> 1) + 32 * (p & 1); }
    }
    float wv[32];
    const float* wp = W + (size_t)(k0 + (lane >> 5)) * N + ((n < N) ? nsrc : 0);
#pragma unroll
    for (int i = 0; i < 32; ++i) wv[i] = wp[(size_t)(2 * i) * N];
    float ksv[32];
    if (kscale) {
#pragma unroll
        for (int i = 0; i < 32; ++i) ksv[i] = kscale[k0 + 2 * i + (lane >> 5)];
    } else {
#pragma unroll
        for (int i = 0; i < 32; ++i) ksv[i] = 1.f;
    }
    if (n >= N) cs = 0.f;
#pragma unroll
    for (int i = 0; i < 32; ++i) {
        const int kk = 2 * i + (lane >> 5);
        scr[kk * 33 + (lane & 31)] = wv[i] * ksv[i] * cs;
    }
    asm volatile("s_waitcnt lgkmcnt(0)" ::: "memory");
    const int c = lane & 7;
#pragma unroll
    for (int j = 0; j < 4; ++j) {
        const int nn = (lane >> 3) + 8 * j; const LAS float* s = scr + (8 * c) * 33 + nn;
        u32x4 o; o.x = pk2(s[0 * 33], s[1 * 33]); o.y = pk2(s[2 * 33], s[3 * 33]); o.z = pk2(s[4 * 33], s[5 * 33]); o.w = pk2(s[6 * 33], s[7 * 33]);
        *(u32x4*)(WT + (size_t)(n0 + nn) * K + k0 + 8 * c) = o;
    }
    asm volatile("s_waitcnt lgkmcnt(0)" ::: "memory");
}
DI void row_to_bf16(const f32x4 (&v)[8], bf16_t* orow, float* rs_out, int lane) {
    float s = 0.f;
#pragma unroll
    for (int j = 0; j < 8; ++j) s += (v[j].x * v[j].x + v[j].y * v[j].y) + (v[j].z * v[j].z + v[j].w * v[j].w);
    if (rs_out) { s = wave_sum(s); if (lane == 0) *rs_out = rsqrtf(s * (1.f / DM) + EPS); }
    u32x2* o8 = (u32x2*)orow + lane;
#pragma unroll
    for (int j = 0; j < 8; ++j) { u32x2 w; w.x = pk2(v[j].x, v[j].y); w.y = pk2(v[j].z, v[j].w); o8[64 * j] = w; }
}
DI void row_to_fp4(const f32x4 (&v)[8], rsrc_t otab, unsigned orow, float* inv_out, int lane) {
    float am = 0.f;
#pragma unroll
    for (int j = 0; j < 8; ++j) am = fmaxf(fmaxf(am, fmaxf(fabsf(v[j].x), fabsf(v[j].y))), fmaxf(fabsf(v[j].z), fabsf(v[j].w)));
#pragma unroll
    for (int o = 1; o < 64; o <<= 1) am = fmaxf(am, __shfl_xor(am, o));
    const float sc = am > 0.f ? 6.f / am : 1.f;
    if (lane == 0) *inv_out = am > 0.f ? am * (1.f / 6.f) : 1.f;
    u32x4 o;
#pragma unroll
    for (int j = 0; j < 4; ++j) {
        unsigned w = 0u;
        w = __builtin_amdgcn_cvt_scalef32_pk_fp4_f32(w, v[2 * j].x * sc, v[2 * j].y * sc, 1.0f, 0);
        w = __builtin_amdgcn_cvt_scalef32_pk_fp4_f32(w, v[2 * j].z * sc, v[2 * j].w * sc, 1.0f, 1);
        w = __builtin_amdgcn_cvt_scalef32_pk_fp4_f32(w, v[2 * j + 1].x * sc, v[2 * j + 1].y * sc, 1.0f, 2);
        w = __builtin_amdgcn_cvt_scalef32_pk_fp4_f32(w, v[2 * j + 1].z * sc, v[2 * j + 1].w * sc, 1.0f, 3);
        o[j] = w;
    }
    bst128_wt(otab, orow + (unsigned)(lane * 16), o);
}
DI int t5_bucket(int d) {
    if (d < 16) return d;
    const float lr = logf((float)d / 16.f) / 2.0794415416798357f;
    int v = 16 + (int)(lr * 16.f);
    return v < 31 ? v : 31;
}
struct Ptrs {
    const float *x, *norm1_g, *w_in, *rel_bias, *ret_gn_g, *cmp_pe, *cmp_w1, *cmp_w2, *nsa_out_g, *w_out, *norm2_g, *peer_wq, *peer_sk, *peer_u, *peer_v, *norm_f_g;
    float* out; unsigned char* ws;
};
DI void row_issue(const Ptrs& P, int m, f32x4 (&v)[8], int lane) {
    if (m < MTOK) {
        const f32x4* xr = (const f32x4*)(P.x + (size_t)m * DM) + lane;
#pragma unroll
        for (int j = 0; j < 8; ++j) v[j] = xr[64 * j];
    } else {
        const f32x4* xr = (const f32x4*)((m < 2 * MTOK) ? P.peer_u + (size_t)(m - MTOK) * DM : P.peer_v + (size_t)(m - 2 * MTOK) * DM);
#pragma unroll
        for (int j = 0; j < 4; ++j) { v[2 * j] = xr[128 * j + lane]; v[2 * j + 1] = xr[128 * j + 64 + lane]; }
    }
}
DI void phase0(const Ptrs& P, ldsb* lds, int tid, int G) {
    const int lane = tid & 63, wid = __builtin_amdgcn_readfirstlane(tid >> 6);
    LAS float* scr = (LAS float*)(lds + wid * 16384);
    const int gw = blockIdx.x * NWAVES + wid, NGW = G * NWAVES;
    unsigned char* ws = P.ws;
    constexpr int I1 = 32 * 184, I2 = 32 * 64, I3 = 32 * 64, I4 = 2 * 64 * 8, I5 = 2 * 4 * 4;
    constexpr int NT = I1 + I2 + I3 + I4 + I5;
    for (int it = gw; it < NT; it += NGW) {
        int r = it;
        if (r < I1) { p0_transpose_item(P.w_in, DM, IN_COLS, (bf16_t*)(ws + WS_WIN), scr, r, 184, lane, P.norm1_g, 1); continue; } r -= I1;
        if (r < I2) { p0_transpose_item(P.w_out, DM, DM, (bf16_t*)(ws + WS_WOUT), scr, r, 64, lane, nullptr, 0); continue; } r -= I2;
        if (r < I3) { p0_transpose_item(P.peer_wq, DM, DM, (bf16_t*)(ws + WS_WQ), scr, r, 64, lane, P.norm2_g, 0); continue; } r -= I3;
        if (r < I4) { const int kv = r / 512; p0_transpose_item(P.cmp_w1 + (size_t)kv * 4096 * 256, 4096, 256, (bf16_t*)(ws + WS_W1T) + (size_t)kv * 256 * 4096, scr, r % 512, 8, lane, nullptr, 0); continue; } r -= I4;
        { const int kv = r / 16; p0_transpose_item(P.cmp_w2 + (size_t)kv * 256 * 128, 256, 128, (bf16_t*)(ws + WS_TAB + TAB_W2T) + (size_t)kv * 128 * 256, scr, r % 16, 4, lane, nullptr, 0); }
    }
    for (int it = gw; it < 512; it += NGW) {
        const int kv = it >> 8, nb = (it >> 6) & 3, kc = it & 63, n = nb * 64 + lane;
        const float* w1 = P.cmp_w1 + (size_t)kv * 4096 * 256; const float* pe = P.cmp_pe + (size_t)kv * 4096;
        float a = 0.f;
#pragma unroll
        for (int k0 = 0; k0 < 64; k0 += 32) {
            float wv[32];
#pragma unroll
            for (int k = 0; k < 32; ++k) wv[k] = w1[(size_t)(kc * 64 + k0 + k) * 256 + n];
#pragma unroll
            for (int k = 0; k < 32; ++k) a += pe[kc * 64 + k0 + k] * wv[k];
        }
        ((float*)(ws + WS_CBP))[(kv * 64 + kc) * 256 + n] = a;
    }
    {
        const int mend = (G == 256) ? MTOK : 3 * MTOK;
        f32x4 cur[8], nxt[8];
        if (gw < mend) row_issue(P, gw, cur, lane);
        for (int m = gw; m < mend; m += NGW) {
            const int mn = m + NGW;
            if (mn < mend) row_issue(P, mn, nxt, lane);
            if (m < MTOK) row_to_bf16(cur, (bf16_t*)(ws + WS_XB) + (size_t)m * DM, (float*)(ws + WS_TAB + TAB_RS1) + m, lane);
            else if (m < 2 * MTOK) { const int e = m - MTOK; row_to_fp4(cur, mk_rsrc(ws + WS_UB, MTOK * (DM / 2)), (unsigned)e * (DM / 2), (float*)(ws + WS_TAB + TAB_UINV) + 2 * e, lane); }
            else { const int e = m - 2 * MTOK; row_to_fp4(cur, mk_rsrc(ws + WS_VB, MTOK * (DM / 2)), (unsigned)e * (DM / 2), (float*)(ws + WS_TAB + TAB_UINV) + 2 * e + 1, lane); }
#pragma unroll
            for (int j = 0; j < 8; ++j) cur[j] = nxt[j];
        }
    }
    const int gt = blockIdx.x * NTHREADS + tid, NGT = G * NTHREADS;
    float* ct = (float*)(ws + WS_TAB + TAB_COS); float* st = (float*)(ws + WS_TAB + TAB_SIN);
    for (int i = gt; i < SEQ * 32; i += NGT) {
        const int pos = i >> 5, k = i & 31;
        const float inv = 1.0f / powf(10000.0f, (float)k / 32.0f);
        const float ang = (float)pos * inv;
        ct[i] = cosf(ang); st[i] = sinf(ang);
    }
    float* lut = (float*)(ws + WS_TAB + TAB_LUT);
    for (int i = gt; i < 128 * 8; i += NGT) { const int d = i >> 3, hh = i & 7; lut[i] = P.rel_bias[t5_bucket(d) * 8 + hh]; }
    bf16_t* skb = (bf16_t*)(ws + WS_TAB + TAB_SK);
    for (int i = gt; i < 2 * 128 * 128; i += NGT) skb[i] = (bf16_t)f2bf(P.peer_sk[i]);
}
namespace pg8 {
struct EpiRowScaleBf16 {
    static constexpr bool PERM = true, AFTER_DRAIN = false;
    bf16_t* O; int ldc; const float* rs; int mode;
    __device__ __forceinline__ void operator()(const f32x4 (&acc)[2][2][4][2], const Unit& u, int wr, int wc, int fr, int fq) const {
        const int row0 = u.pm * BM + wr * 64 + fr, col0 = u.pn * BM + wc * 32 + 8 * fq;
        const rsrc_t ro = mk_rsrc(O, (unsigned)MTOK * (unsigned)ldc * 2u);
        float scv[2][4];
#pragma unroll
        for (int ai = 0; ai < 2; ++ai)
#pragma unroll
            for (int m = 0; m < 4; ++m) scv[ai][m] = rs[row0 + ai * HALF + m * 16];
        __builtin_amdgcn_sched_barrier(0);
#pragma unroll
        for (int ai = 0; ai < 2; ++ai)
#pragma unroll
            for (int m = 0; m < 4; ++m) {
                const int row = row0 + ai * HALF + m * 16;
                float sc = scv[ai][m]; if (mode == 1) sc = rsqrtf(sc * (1.f / 2048.f) + 1e-6f);
                const unsigned rowo = (unsigned)(row * ldc + col0) * 2u;
#pragma unroll
                for (int bj = 0; bj < 2; ++bj) {
                    const f32x4 v0 = acc[ai][bj][m][0] * sc, v1 = acc[ai][bj][m][1] * sc;
                    u32x4 w; w.x = cvt_pk_bf16(v0[0], v0[1]); w.y = cvt_pk_bf16(v0[2], v0[3]); w.z = cvt_pk_bf16(v1[0], v1[1]); w.w = cvt_pk_bf16(v1[2], v1[3]);
                    bst128_wt(ro, rowo + bj * HALF * 2, w);
                }
            }
    }
};
struct EpiProj {
    static constexpr bool PERM = true, AFTER_DRAIN = false;
    bf16_t* O; int ldc; const float* rs; const float* ct; const float* st;
    __device__ __forceinline__ void operator()(const f32x4 (&acc)[2][2][4][2], const Unit& u, int wr, int wc, int fr, int fq) const {
        const int row0 = u.pm * BM + wr * 64 + fr, col0 = u.pn * BM + wc * 32 + 8 * fq;
        const bool rot = u.pn < 4;
        const rsrc_t ro = mk_rsrc(O, (unsigned)MTOK * (unsigned)ldc * 2u);
        float scv[2][4];
#pragma unroll
        for (int ai = 0; ai < 2; ++ai)
#pragma unroll
            for (int m = 0; m < 4; ++m) scv[ai][m] = rs[row0 + ai * HALF + m * 16];
        __builtin_amdgcn_sched_barrier(0);
#pragma unroll
        for (int ai = 0; ai < 2; ++ai) {
            f32x4 cv[4][2], sv[4][2];
            if (rot) {
#pragma unroll
                for (int m = 0; m < 4; ++m)
#pragma unroll
                    for (int bj = 0; bj < 2; ++bj) {
                        const int t = (row0 + ai * HALF + m * 16) & 2047, i0 = ((col0 + bj * HALF) & 63) >> 1;
                        cv[m][bj] = *(const f32x4*)(ct + t * 32 + i0); sv[m][bj] = *(const f32x4*)(st + t * 32 + i0);
                    }
                __builtin_amdgcn_sched_barrier(0);
            }
#pragma unroll
            for (int m = 0; m < 4; ++m) {
                const int row = row0 + ai * HALF + m * 16; const int t = row & 2047;
                const float sc = scv[ai][m];
                const unsigned rowo = (unsigned)(row * ldc + col0) * 2u;
#pragma unroll
                for (int bj = 0; bj < 2; ++bj) {
                    f32x4 v0 = acc[ai][bj][m][0] * sc, v1 = acc[ai][bj][m][1] * sc;
                    if (rot) {
                        const int col = col0 + bj * HALF, h = (col >> 6) & 7;
                        const float l2g = __log2f(1.f - exp2f(-5.f - (float)h));
                        const float dsc = exp2f(l2g * (float)(col < 512 ? (t & 31) : 63 - (t & 63)));
                        const f32x4 c4 = cv[m][bj], s4 = sv[m][bj];
                        f32x4 y0, y1;
                        y0[0] = (v0[0] * c4[0] - v0[1] * s4[0]) * dsc; y0[1] = (v0[0] * s4[0] + v0[1] * c4[0]) * dsc;
                        y0[2] = (v0[2] * c4[1] - v0[3] * s4[1]) * dsc; y0[3] = (v0[2] * s4[1] + v0[3] * c4[1]) * dsc;
                        y1[0] = (v1[0] * c4[2] - v1[1] * s4[2]) * dsc; y1[1] = (v1[0] * s4[2] + v1[1] * c4[2]) * dsc;
                        y1[2] = (v1[2] * c4[3] - v1[3] * s4[3]) * dsc; y1[3] = (v1[2] * s4[3] + v1[3] * c4[3]) * dsc;
                        v0 = y0; v1 = y1;
                    }
                    u32x4 w; w.x = cvt_pk_bf16(v0[0], v0[1]); w.y = cvt_pk_bf16(v0[2], v0[3]); w.z = cvt_pk_bf16(v1[0], v1[1]); w.w = cvt_pk_bf16(v1[2], v1[3]);
                    bst128_wt(ro, rowo + bj * HALF * 2, w);
                }
            }
        }
    }
};
struct EpiResidual {
    static constexpr bool PERM = true, AFTER_DRAIN = false;
    const bf16_t* X; float* H; bf16_t* HB; float* ssq; int ldc;
    __device__ __forceinline__ void operator()(const f32x4 (&acc)[2][2][4][2], const Unit& u, int wr, int wc, int fr, int fq) const {
        const int row0 = u.pm * BM + wr * 64 + fr, col0 = u.pn * BM + wc * 32 + 8 * fq;
        const rsrc_t rx = mk_rsrc(X, (unsigned)MTOK * (unsigned)ldc * 2u), rh = mk_rsrc(HB, (unsigned)MTOK * (unsigned)ldc * 2u);
#pragma unroll
        for (int ai = 0; ai < 2; ++ai) {
            u32x4 xv[4][2];
#pragma unroll
            for (int m = 0; m < 4; ++m)
#pragma unroll
                for (int bj = 0; bj < 2; ++bj) xv[m][bj] = bld128(rx, (unsigned)((row0 + ai * HALF + m * 16) * ldc + col0 + bj * HALF) * 2u, 0);
            asm volatile("s_waitcnt vmcnt(0)" ::: "memory");
            __builtin_amdgcn_sched_barrier(0);
#pragma unroll
            for (int m = 0; m < 4; ++m) {
                const int row = row0 + ai * HALF + m * 16; float sq = 0.f;
#pragma unroll
                for (int bj = 0; bj < 2; ++bj) {
                    const u32x4 xr = xv[m][bj];
                    const f32x4 h0 = f32x4{__builtin_bit_cast(float, xr.x << 16), __builtin_bit_cast(float, xr.x & 0xffff0000u), __builtin_bit_cast(float, xr.y << 16), __builtin_bit_cast(float, xr.y & 0xffff0000u)} + acc[ai][bj][m][0];
                    const f32x4 h1 = f32x4{__builtin_bit_cast(float, xr.z << 16), __builtin_bit_cast(float, xr.z & 0xffff0000u), __builtin_bit_cast(float, xr.w << 16), __builtin_bit_cast(float, xr.w & 0xffff0000u)} + acc[ai][bj][m][1];
                    sq += ((h0[0] * h0[0] + h0[1] * h0[1]) + (h0[2] * h0[2] + h0[3] * h0[3])) + ((h1[0] * h1[0] + h1[1] * h1[1]) + (h1[2] * h1[2] + h1[3] * h1[3]));
                    u32x4 w; w.x = cvt_pk_bf16(h0[0], h0[1]); w.y = cvt_pk_bf16(h0[2], h0[3]); w.z = cvt_pk_bf16(h1[0], h1[1]); w.w = cvt_pk_bf16(h1[2], h1[3]);
                    bst128_wt(rh, (unsigned)(row * ldc + col0 + bj * HALF) * 2u, w);
                }
                sq += __shfl_xor(sq, 16); sq += __shfl_xor(sq, 32);
                if (fq == 0) unsafeAtomicAdd(ssq + row, sq);
            }
        }
    }
};
}

DI void load8bf(const bf16_t* p, float (&o)[8]) {
    const u32x4 v = *(const u32x4*)p;
    o[0] = bflo(v.x); o[1] = bfhi(v.x); o[2] = bflo(v.y); o[3] = bfhi(v.y); o[4] = bflo(v.z); o[5] = bfhi(v.z); o[6] = bflo(v.w); o[7] = bfhi(v.w);
}
DI void load8f(const float* p, float (&o)[8]) {
    const f32x4 a = *(const f32x4*)p, b = *(const f32x4*)(p + 4);
    o[0] = a[0]; o[1] = a[1]; o[2] = a[2]; o[3] = a[3]; o[4] = b[0]; o[5] = b[1]; o[6] = b[2]; o[7] = b[3];
}
DI u32x4 pack8(const float (&v)[8]) { u32x4 w = {cvtpk(v[0], v[1]), cvtpk(v[2], v[3]), cvtpk(v[4], v[5]), cvtpk(v[6], v[7])}; return w; }

DI void convert_table_rows(const Ptrs& P, int which, int first, int stride, int lane, int end = MTOK) {
    unsigned char* ws = P.ws;
    const int base = (which + 1) * MTOK;
    unsigned char* dst = ws + (which ? WS_VB : WS_UB); float* inv = (float*)(ws + WS_TAB + TAB_UINV) + which;
    const rsrc_t rdst = mk_rsrc(dst, MTOK * (DM / 2));
    f32x4 cur[8], nxt[8];
    if (first < end) row_issue(P, base + first, cur, lane);
    for (int e = first; e < end; e += stride) {
        const int en = e + stride;
        if (en < end) row_issue(P, base + en, nxt, lane);
        row_to_fp4(cur, rdst, (unsigned)e * (DM / 2), inv + 2 * e, lane);
#pragma unroll
        for (int j = 0; j < 8; ++j) cur[j] = nxt[j];
    }
}
DI void retention_state_units(ldsb* lds, const Ptrs& P, int it0, int G, int tid) {
    const int lane = tid & 63, wid = __builtin_amdgcn_readfirstlane(tid >> 6), hi = lane >> 5;
    const bf16_t* proj = (const bf16_t*)(P.ws + WS_PROJ);
    ldsb* Kl = lds; ldsb* Vl = lds + 16384;
    u32x4 kq[2], vq[4];
#define RS_LOAD(IT) do { const int bh_ = (IT) & 63, b_ = bh_ >> 3, h_ = bh_ & 7, c_ = (IT) >> 6; const size_t row0_ = (size_t)b_ * SEQ + 128 * c_; \
        _Pragma("unroll") for (int i = 0; i < 2; ++i) { const int ci = tid + 512 * i, row = ci >> 3, ch = ci & 7; kq[i] = *(const u32x4*)(proj + (row0_ + row) * NPAD + C_RK + h_ * 64 + 8 * ch); } \
        _Pragma("unroll") for (int i = 0; i < 4; ++i) { const int ci = tid + 512 * i, row = ci >> 4, ch = ci & 15; vq[i] = *(const u32x4*)(proj + (row0_ + row) * NPAD + C_RV + h_ * 128 + 8 * ch); } } while (0)
    if (it0 < 1024) RS_LOAD(it0);
    for (int it = it0; it < 1024; it += G) {
        const int bh = it & 63, b = bh >> 3, h = bh & 7, c = it >> 6;
        bf16_t* kvt = (bf16_t*)(P.ws + WS_KVT) + ((size_t)((b * 8 + h) * 16 + c)) * 128 * 64;
        const float l2g = log2f(1.f - exp2f(-5.f - (float)h));
        __syncthreads();
#pragma unroll
        for (int i = 0; i < 2; ++i) { const int ci = tid + 512 * i, row = ci >> 3, ch = ci & 7; *(LAS u32x4*)(Kl + (row >> 6) * 8192 + offk64(row & 63, ch)) = kq[i]; }
#pragma unroll
        for (int i = 0; i < 4; ++i) { const int ci = tid + 512 * i, row = ci >> 4, ch = ci & 15; *(LAS u32x4*)(Vl + (row >> 6) * 16384 + offb(row & 63, ch)) = vq[i]; }
        if (it + G < 1024) RS_LOAD(it + G);
        __syncthreads();
        const int dkb = wid & 1, cb = wid >> 1;
        const unsigned hh2 = lane >> 5, blk = (lane >> 4) & 1, q = (lane & 15) >> 2, p = lane & 3;
        f32x16 acc;
#pragma unroll
        for (int r = 0; r < 16; ++r) acc[r] = 0.f;
#pragma unroll
        for (int tile = 0; tile < 2; ++tile) {
#pragma unroll
            for (int s4 = 0; s4 < 4; ++s4) {
                const unsigned r_lo = 16 * s4 + 4 * hh2 + q, r_hi = r_lo + 8;
                const unsigned kch = 4 * dkb + 2 * blk + (p >> 1), vch = 4 * cb + 2 * blk + (p >> 1);
                const s16x4 alo = vtr(Kl + tile * 8192 + offk64(r_lo, kch) + 8 * (p & 1)), ahi = vtr(Kl + tile * 8192 + offk64(r_hi, kch) + 8 * (p & 1));
                const s16x4 blo = vtr(Vl + tile * 16384 + offb(r_lo, vch) + 8 * (p & 1)), bhi = vtr(Vl + tile * 16384 + offb(r_hi, vch) + 8 * (p & 1));
                const bf16x8 af = {alo[0], alo[1], alo[2], alo[3], ahi[0], ahi[1], ahi[2], ahi[3]};
                const bf16x8 bfv = {blo[0], blo[1], blo[2], blo[3], bhi[0], bhi[1], bhi[2], bhi[3]};
                acc = MFMA32(af, bfv, acc);
            }
            if (tile == 0) { const float g64 = exp2f(l2g * 64.f);
#pragma unroll
                for (int r = 0; r < 16; ++r) acc[r] *= g64; }
        }
        bf16_t* orow = kvt + (size_t)(32 * cb + (lane & 31)) * 64 + 32 * dkb + 4 * hi;
#pragma unroll
        for (int g4 = 0; g4 < 4; ++g4) {
            u32x2 w; w.x = cvtpk(acc[4 * g4], acc[4 * g4 + 1]); w.y = cvtpk(acc[4 * g4 + 2], acc[4 * g4 + 3]);
            *(u32x2*)(orow + 8 * g4) = w;
        }
    }
#undef RS_LOAD
}
DI void retention_scan_unit(const Ptrs& P, int u, int tid) {
    const int gi = u * 512 + tid, bh = gi >> 10, within = gi & 1023, h = bh & 7;
    bf16_t* base = (bf16_t*)(P.ws + WS_KVT) + (size_t)bh * 16 * 8192 + within * 8;
    const float g128 = exp2f(log2f(1.f - exp2f(-5.f - (float)h)) * 128.f);
    const rsrc_t rb_ = mk_rsrc(P.ws + WS_KVT, 64 * 16 * 8192 * 2); const unsigned boff = ((unsigned)bh * 16u * 8192u + (unsigned)within * 8u) * 2u;
    u32x4 v[15];
#pragma unroll
    for (int c = 0; c < 15; ++c) v[c] = *(const u32x4*)(base + c * 8192);
    float a[8];
#pragma unroll
    for (int j = 0; j < 8; ++j) a[j] = 0.f;
#pragma unroll
    for (int c = 0; c < 15; ++c) {
        const u32x4 w = v[c];
        const float f[8] = {bflo(w.x), bfhi(w.x), bflo(w.y), bfhi(w.y), bflo(w.z), bfhi(w.z), bflo(w.w), bfhi(w.w)};
#pragma unroll
        for (int j = 0; j < 8; ++j) a[j] = a[j] * g128 + f[j];
        bst128_wt(rb_, boff + (unsigned)(c * 16384), pack8(a));
    }
}
DI void retention_out_unit(ldsb* lds, const Ptrs& P, int b, int h, int jp, int tid) {
    const int lane = tid & 63, wid = __builtin_amdgcn_readfirstlane(tid >> 6), r32 = lane & 31, hi = lane >> 5;
    const bf16_t* proj = (const bf16_t*)(P.ws + WS_PROJ);
    const bf16_t* kvt = (const bf16_t*)(P.ws + WS_KVT) + ((size_t)((b * 8 + h) * 16)) * 128 * 64;
    bf16_t* mix = (bf16_t*)(P.ws + WS_MIX);
    ldsb* Kl = lds; ldsb* Vl = lds + 32768; ldsb* Rl = lds + 98304;
    const float l2g = log2f(1.f - exp2f(-5.f - (float)h));
    const int c0 = 2 * jp; const size_t row0 = (size_t)b * SEQ + 128 * c0;
    const int cw = wid >> 2, rb = wid & 3;
    const int Tq0 = 128 * (c0 + cw) + 32 * rb, tq = Tq0 + r32; const size_t rowq = (size_t)b * SEQ + tq;
    bf16x8 qf[4];
    __syncthreads();
    {
        u32x4 kq[4], vq[8], r0[2], r1[2];
        {
            const bf16_t* qp = proj + rowq * NPAD + C_RQ + h * 64 + 8 * hi;
#pragma unroll
            for (int s4 = 0; s4 < 4; ++s4) qf[s4] = *(const bf16x8*)(qp + 16 * s4);
        }
#pragma unroll
        for (int i = 0; i < 4; ++i) { const int ci = tid + 512 * i, row = ci >> 3, ch = ci & 7; kq[i] = *(const u32x4*)(proj + (row0 + row) * NPAD + C_RK + h * 64 + 8 * ch); }
#pragma unroll
        for (int i = 0; i < 8; ++i) { const int ci = tid + 512 * i, row = ci >> 4, ch = ci & 15; vq[i] = *(const u32x4*)(proj + (row0 + row) * NPAD + C_RV + h * 128 + 8 * ch); }
#pragma unroll
        for (int i = 0; i < 2; ++i) {
            const int ci = tid + 512 * i, row = ci >> 3, ch = ci & 7;
            r0[i] = u32x4{0u, 0u, 0u, 0u};
            if (c0 > 0) r0[i] = *(const u32x4*)(kvt + ((size_t)(c0 - 1) * 128 + row) * 64 + 8 * ch);
            r1[i] = *(const u32x4*)(kvt + ((size_t)c0 * 128 + row) * 64 + 8 * ch);
        }
        __builtin_amdgcn_sched_barrier(0);
#pragma unroll
        for (int i = 0; i < 4; ++i) { const int ci = tid + 512 * i, row = ci >> 3, ch = ci & 7; *(LAS u32x4*)(Kl + (row >> 6) * 8192 + offk64(row & 63, ch)) = kq[i]; }
#pragma unroll
        for (int i = 0; i < 8; ++i) { const int ci = tid + 512 * i, row = ci >> 4, ch = ci & 15; *(LAS u32x4*)(Vl + (row >> 6) * 16384 + offb(row & 63, ch)) = vq[i]; }
#pragma unroll
        for (int i = 0; i < 2; ++i) { const int ci = tid + 512 * i, row = ci >> 3, ch = ci & 7; *(LAS u32x4*)(Rl + offk64(row, ch)) = r0[i]; *(LAS u32x4*)(Rl + 16384 + offk64(row, ch)) = r1[i]; }
    }
    __syncthreads();
    f32x16 o[4];
#pragma unroll
    for (int c = 0; c < 4; ++c)
#pragma unroll
        for (int r = 0; r < 16; ++r) o[c][r] = 0.f;
    {
        ldsb* Rc = Rl + cw * 16384;
#pragma unroll
        for (int c = 0; c < 4; ++c)
#pragma unroll
            for (int s4 = 0; s4 < 4; ++s4) {
                const bf16x8 rf = *(LAS bf16x8*)(Rc + offk64(32 * c + r32, 2 * s4 + hi));
                o[c] = MFMA32(qf[s4], rf, o[c]);
            }
        const float gx = exp2f(l2g * (float)(32 * rb + 1));
#pragma unroll
        for (int c = 0; c < 4; ++c)
#pragma unroll
            for (int r = 0; r < 16; ++r) o[c][r] *= gx;
    }
#pragma unroll
    for (int kt = 0; kt < 2; ++kt) {
        const int Tk0 = 128 * (c0 + cw) + 64 * kt;
        if (Tk0 <= Tq0 + 31) {
            ldsb* Kt = Kl + (2 * cw + kt) * 8192; ldsb* Vt = Vl + (2 * cw + kt) * 16384;
            f32x16 p0, p1;
#pragma unroll
            for (int r = 0; r < 16; ++r) { p0[r] = 0.f; p1[r] = 0.f; }
            qk64(p0, p1, Kt, qf, r32, hi);
            const float cst = exp2f(l2g * (float)(Tq0 - Tk0 - 63));
#pragma unroll
            for (int r = 0; r < 16; ++r) {
                const int kv0 = Tk0 + crow(r, hi);
                p0[r] = (kv0 <= tq) ? p0[r] * cst : 0.f;
                p1[r] = (kv0 + 32 <= tq) ? p1[r] * cst : 0.f;
            }
            pv128(o, p0, p1, Vt, lane);
        }
    }
    const float* gn = P.ret_gn_g;
    unsigned short rga[4][16];
#pragma unroll
    for (int c = 0; c < 4; ++c)
#pragma unroll
        for (int r = 0; r < 16; ++r) rga[c][r] = proj[((size_t)b * SEQ + Tq0 + crow(r, hi)) * NPAD + C_RG + h * 128 + 32 * c + r32];
    float gcols[4];
#pragma unroll
    for (int c = 0; c < 4; ++c) gcols[c] = gn[h * 128 + 32 * c + r32];
    __builtin_amdgcn_sched_barrier(0);
    float mu[16], rstd[16];
#pragma unroll
    for (int r = 0; r < 16; ++r) {
        float s1 = (o[0][r] + o[1][r]) + (o[2][r] + o[3][r]);
        s1 = half_sum(s1);
        mu[r] = s1 * (1.f / 128.f);
        float dv = 0.f;
#pragma unroll
        for (int c = 0; c < 4; ++c) { const float d = o[c][r] - mu[r]; dv += d * d; }
        dv = half_sum(dv);
        rstd[r] = rsqrtf(dv * (1.f / 128.f) + EPS);
    }
#pragma unroll
    for (int c = 0; c < 4; ++c) {
        const int col = h * 128 + 32 * c + r32;
        const unsigned short (&rgv)[16] = rga[c];
        const float gcol = gcols[c];
#pragma unroll
        for (int r = 0; r < 16; ++r) {
            const float rg = bf2f(rgv[r]);
            const float y = (o[c][r] - mu[r]) * rstd[r] * gcol;
            const float sg = rg / (1.f + __expf(-rg));
            mix[((size_t)b * SEQ + Tq0 + crow(r, hi)) * DM + col] = (bf16_t)f2bf(y * sg);
        }
        __builtin_amdgcn_sched_barrier(0);
    }
}


DI void compress_step1(ldsb* lds, const Ptrs& P, int kvs, int bg, int ks, int tid) {
    const int lane = tid & 63, wid = __builtin_amdgcn_readfirstlane(tid >> 6), r32 = lane & 31, hi = lane >> 5;
    const int b = bg >> 1, g = bg & 1;
    const bf16_t* proj = (const bf16_t*)(P.ws + WS_PROJ);
    const bf16_t* w1t = (const bf16_t*)(P.ws + WS_W1T) + (size_t)kvs * 256 * 4096;
    float* part = (float*)(P.ws + (kvs ? WS_CPART1 : WS_CPART0)) + ((size_t)(bg * 8 + ks) * 128) * 256;
    ldsb* Al = lds;
    const bf16_t* asrc = proj + ((size_t)b * SEQ + 16 * (tid >> 4)) * NPAD + C_KV + (kvs * 2 + g) * 128 + 8 * (tid & 15);
    const bf16_t* brow = w1t + (size_t)(32 * wid + r32) * 4096 + 8 * hi;
    f32x16 acc[4];
#pragma unroll
    for (int rb = 0; rb < 4; ++rb)
#pragma unroll
        for (int r = 0; r < 16; ++r) acc[rb][r] = 0.f;
    u32x4 areg[4], breg[8];
    const int l0 = 4 * ks;
#define C1_LOAD(l) do { _Pragma("unroll") for (int i_ = 0; i_ < 4; ++i_) { areg[i_] = *(const u32x4*)(asrc + ((size_t)(512 * i_) + (l)) * NPAD); } \
                        _Pragma("unroll") for (int s_ = 0; s_ < 8; ++s_) breg[s_] = *(const u32x4*)(brow + (l) * 128 + 16 * s_); } while (0)
    C1_LOAD(l0);
    for (int li = 0; li < 4; ++li) {
        __syncthreads();
#pragma unroll
        for (int i = 0; i < 4; ++i) {
            const int row = (tid >> 4) + 32 * i; u32x4 v = areg[i];
            if (row == 127) { v.x = 0u; v.y = 0u; v.z = 0u; v.w = 0u; }
            *(LAS u32x4*)(Al + offb(row, tid & 15)) = v;
        }
        bf16x8 bf[8];
#pragma unroll
        for (int s = 0; s < 8; ++s) bf[s] = __builtin_bit_cast(bf16x8, breg[s]);
        if (li < 3) C1_LOAD(l0 + li + 1);
        __syncthreads();
#pragma unroll
        for (int rb = 0; rb < 4; ++rb)
#pragma unroll
            for (int s = 0; s < 8; ++s) {
                const bf16x8 af = *(LAS bf16x8*)(Al + offb(32 * rb + r32, 2 * s + hi));
                acc[rb] = MFMA32(af, bf[s], acc[rb]);
            }
    }
#undef C1_LOAD
#pragma unroll
    for (int rb = 0; rb < 4; ++rb)
#pragma unroll
        for (int r = 0; r < 16; ++r) part[(size_t)(32 * rb + crow(r, hi)) * 256 + 32 * wid + r32] = acc[rb][r];
}
DI void compress_step2(ldsb* lds, const Ptrs& P, int kvs, int bg, int cb, int tid) {
    const int lane = tid & 63, wid = __builtin_amdgcn_readfirstlane(tid >> 6), r32 = lane & 31, hi = lane >> 5;
    const bf16_t* w2t = (const bf16_t*)(P.ws + WS_TAB + TAB_W2T) + (size_t)kvs * 128 * 256;
    const float* cbias = (const float*)(P.ws + WS_CBP) + (size_t)kvs * 64 * 256;
    const float* part = (const float*)(P.ws + (kvs ? WS_CPART1 : WS_CPART0)) + ((size_t)(bg * 8) * 128) * 256;
    bf16_t* outp = (bf16_t*)(P.ws + (kvs ? WS_VCMP : WS_KCMP)) + ((size_t)bg * 128) * 128;
    const int n = 32 * wid + r32;
    float bn = 0.f;
    {
        float bv[64];
#pragma unroll
        for (int kc = 0; kc < 64; ++kc) bv[kc] = cbias[kc * 256 + n];
#pragma unroll
        for (int kc = 0; kc < 64; ++kc) bn += bv[kc];
    }
    LAS bf16_t* hid = (LAS bf16_t*)(lds + L_HID);
    __syncthreads();
#pragma unroll
    for (int rh = 0; rh < 2; ++rh) {
        float pv[8][8];
#pragma unroll
        for (int r8 = 0; r8 < 8; ++r8)
#pragma unroll
            for (int k8 = 0; k8 < 8; ++k8) pv[r8][k8] = part[((size_t)k8 * 128 + 32 * cb + crow(8 * rh + r8, hi)) * 256 + n];
        __builtin_amdgcn_sched_barrier(0);
#pragma unroll
        for (int r8 = 0; r8 < 8; ++r8) {
            float a = bn;
#pragma unroll
            for (int k8 = 0; k8 < 8; ++k8) a += pv[r8][k8];
            hid[crow(8 * rh + r8, hi) * 256 + n] = (bf16_t)f2bf(gelu_tanh(a));
        }
    }
    __syncthreads();
    if (wid < 4) {
        f32x16 o2;
#pragma unroll
        for (int r = 0; r < 16; ++r) o2[r] = 0.f;
#pragma unroll
        for (int s = 0; s < 16; ++s) {
            const bf16x8 af = *(LAS bf16x8*)(hid + r32 * 256 + 16 * s + 8 * hi);
            const bf16x8 bfr = *(const bf16x8*)(w2t + (size_t)(32 * wid + r32) * 256 + 16 * s + 8 * hi);
            o2 = MFMA32(af, bfr, o2);
        }
#pragma unroll
        for (int r = 0; r < 16; ++r) outp[(size_t)(cb * 32 + crow(r, hi)) * 128 + 32 * wid + r32] = (bf16_t)f2bf(o2[r]);
    }
}

constexpr float NEGF = -1e30f;
DI void scale_rows(f32x16 (&o)[4], float f, LAS float* wsf, int r32, int hi) {
    if (hi == 0) wsf[r32] = f;
    asm volatile("s_waitcnt lgkmcnt(0)" ::: "memory");
#pragma unroll
    for (int r = 0; r < 16; ++r) {
        const float fr = wsf[crow(r, hi)];
#pragma unroll
        for (int c = 0; c < 4; ++c) o[c][r] *= fr;
    }
    asm volatile("s_waitcnt lgkmcnt(0)" ::: "memory");
}
template <int MODE>
DI void acc_rows(rsrc_t otr, unsigned otv, f32x16 (&o)[4], float f, LAS float* wsf, int r32, int hi) {
    if (hi == 0) wsf[r32] = f;
    asm volatile("s_waitcnt lgkmcnt(0)" ::: "memory");
    float fr[16];
#pragma unroll
    for (int r = 0; r < 16; ++r) fr[r] = wsf[crow(r, hi)];
    if (MODE < 2) {
#pragma unroll
        for (int c = 0; c < 4; ++c)
#pragma unroll
            for (int k = 0; k < 2; ++k) {
                u32x4 q;
#pragma unroll
                for (int j = 0; j < 4; ++j) q[j] = cvtpk(fr[8 * k + 2 * j] * o[c][8 * k + 2 * j], fr[8 * k + 2 * j + 1] * o[c][8 * k + 2 * j + 1]);
                bst128_wt(otr, otv + (unsigned)(MODE * 8192 + (c * 2 + k) * 1024), q);
            }
    } else {
        u32x4 pa[8], pb[8];
#pragma unroll
        for (int i = 0; i < 8; ++i) {
            pa[i] = __builtin_amdgcn_raw_buffer_load_b128(otr, (int)(otv + (unsigned)(i * 1024)), 0, 16);
            pb[i] = __builtin_amdgcn_raw_buffer_load_b128(otr, (int)(otv + (unsigned)(8192 + i * 1024)), 0, 16);
        }
        __builtin_amdgcn_sched_barrier(0);
#pragma unroll
        for (int c = 0; c < 4; ++c)
#pragma unroll
            for (int k = 0; k < 2; ++k)
#pragma unroll
                for (int j = 0; j < 4; ++j) {
                    const unsigned a = pa[c * 2 + k][j], bq = pb[c * 2 + k][j]; const int r = 8 * k + 2 * j;
                    o[c][r] = fr[r] * o[c][r] + (bflo(a) + bflo(bq));
                    o[c][r + 1] = fr[r + 1] * o[c][r + 1] + (bfhi(a) + bfhi(bq));
                }
    }
    asm volatile("s_waitcnt lgkmcnt(0)" ::: "memory");
}
template <int MODE>
DI void attn_step(f32x16 (&o)[4], float& m, float& l, ldsb* Kl, ldsb* Vl, ldsb* Ql, const LAS float* lutl, LAS float* wsf,
                  int t, int kpos0, int hh, bool selbit, int lane, int r32, int hi) {
    f32x16 p0, p1;
#pragma unroll
    for (int r = 0; r < 16; ++r) { p0[r] = 0.f; p1[r] = 0.f; }
    qk128l(p0, p1, Kl, Ql, lane, r32, hi);
    float tmax = NEGF;
    const int tw0 = __builtin_amdgcn_readfirstlane(t) & ~7;
    const bool farq = (tw0 - (kpos0 + 63) >= 128) && (MODE == 0 || (tw0 + 7 - kpos0) < 512);
    float cadd = 0.f;
    if (farq) {
        const float cb = lutl[127 * 8 + hh];
        float mx = fmaxf(p0[0], p1[0]);
#pragma unroll
        for (int r = 1; r < 16; ++r) mx = fmaxf(fmaxf(mx, p0[r]), p1[r]);
        const bool lane_ok = (MODE == 1) || selbit;
        tmax = lane_ok ? mx + cb : NEGF;
        cadd = lane_ok ? cb : NEGF;
    } else {
        int tb = t - kpos0 - 4 * hi; asm volatile("" : "+v"(tb));
        float b0[16], b1[16];
#pragma unroll
        for (int r = 0; r < 16; ++r) {
            const int d0 = tb - ((r & 3) + 8 * (r >> 2)), d1 = d0 - 32;
            const int i0 = d0 < 0 ? 0 : (d0 > 127 ? 127 : d0), i1 = d1 < 0 ? 0 : (d1 > 127 ? 127 : d1);
            b0[r] = lutl[i0 * 8 + hh]; b1[r] = lutl[i1 * 8 + hh];
        }
        asm volatile("" : "+v"(b0[0]), "+v"(b0[1]), "+v"(b0[2]), "+v"(b0[3]), "+v"(b0[4]), "+v"(b0[5]), "+v"(b0[6]), "+v"(b0[7]), "+v"(b0[8]), "+v"(b0[9]), "+v"(b0[10]), "+v"(b0[11]), "+v"(b0[12]), "+v"(b0[13]), "+v"(b0[14]), "+v"(b0[15]));
        asm volatile("" : "+v"(b1[0]), "+v"(b1[1]), "+v"(b1[2]), "+v"(b1[3]), "+v"(b1[4]), "+v"(b1[5]), "+v"(b1[6]), "+v"(b1[7]), "+v"(b1[8]), "+v"(b1[9]), "+v"(b1[10]), "+v"(b1[11]), "+v"(b1[12]), "+v"(b1[13]), "+v"(b1[14]), "+v"(b1[15]));
#pragma unroll
        for (int r = 0; r < 16; ++r) {
            const int d0 = tb - ((r & 3) + 8 * (r >> 2)), d1 = d0 - 32;
            const bool v0 = (MODE == 0) ? (selbit && d0 >= 0) : (d0 >= 0 && d0 < 512);
            const bool v1 = (MODE == 0) ? (selbit && d1 >= 0) : (d1 >= 0 && d1 < 512);
            p0[r] = v0 ? p0[r] + b0[r] : NEGF;
            p1[r] = v1 ? p1[r] + b1[r] : NEGF;
            tmax = fmaxf(tmax, fmaxf(p0[r], p1[r]));
        }
    }
    tmax = fmaxf(tmax, __shfl_xor(tmax, 32));
    if (__any(tmax > m + 8.f)) {
        const float mnew = (tmax > m + 8.f) ? tmax : m;
        const float f = __builtin_amdgcn_exp2f(m - mnew);
        l *= f; m = mnew;
        scale_rows(o, f, wsf, r32, hi);
    }
    const float csub = cadd - ((m < -1e29f) ? 0.f : m);
    float rs = 0.f;
#pragma unroll
    for (int r = 0; r < 16; ++r) {
        const float e0 = __builtin_amdgcn_exp2f(p0[r] + csub), e1 = __builtin_amdgcn_exp2f(p1[r] + csub);
        p0[r] = e0; p1[r] = e1; rs += e0 + e1;
    }
    l += rs;
    pv128(o, p0, p1, Vl, lane);
}

DI void nsa_unit(ldsb* lds, const Ptrs& P, int b, int g, int qi, int tid) {
    const int lane = tid & 63, wid = __builtin_amdgcn_readfirstlane(tid >> 6), r32 = lane & 31, hi = lane >> 5;
    const bf16_t* proj = (const bf16_t*)(P.ws + WS_PROJ);
    const bf16_t* kcmp = (const bf16_t*)(P.ws + WS_KCMP) + (size_t)(b * 2 + g) * 128 * 128;
    const bf16_t* vcmp = (const bf16_t*)(P.ws + WS_VCMP) + (size_t)(b * 2 + g) * 128 * 128;
    const float* lutg = (const float*)(P.ws + WS_TAB + TAB_LUT);
    bf16_t* mix = (bf16_t*)(P.ws + WS_MIX);
    ldsb* Kl = lds + L_K; ldsb* Vl = lds + L_V;
    LAS float* wsf = (LAS float*)(lds + L_WSF) + wid * 64;
    LAS float* lutl = (LAS float*)(lds + L_LUT);
    LAS unsigned* misc = (LAS unsigned*)(lds + L_MISC);
    const int head = r32 >> 3, tl = r32 & 7, hh = g * 4 + head;
    const int t = 64 * qi + 8 * wid + tl; const size_t row = (size_t)b * SEQ + t;
    __syncthreads();
    const int ntile = ((64 * qi + 63) >= 1055) ? 2 : 1;
    ldsb* Ql = lds + L_Q + wid * 8192;
    unsigned short gr0, gr1, gr2;
    {
        { const bf16_t* gp = proj + row * NPAD + C_GATE + hh * 3; gr0 = gp[0]; gr1 = gp[1]; gr2 = gp[2]; }
        const float l0 = lutg[tid], l1 = lutg[tid + NTHREADS];
        const bf16_t* qp = proj + row * NPAD + C_NQ + hh * 128 + 8 * hi;
        bf16x8 qv[8];
#pragma unroll
        for (int s = 0; s < 8; ++s) qv[s] = *(const bf16x8*)(qp + 16 * s);
        const int srow = tid >> 4, sch = tid & 15;
        u32x4 ck[4], cv[4];
#pragma unroll
        for (int i = 0; i < 2; ++i) { ck[i] = *(const u32x4*)(kcmp + (size_t)(srow + 32 * i) * 128 + 8 * sch); cv[i] = *(const u32x4*)(vcmp + (size_t)(srow + 32 * i) * 128 + 8 * sch); }
        if (ntile == 2) {
#pragma unroll
            for (int i = 0; i < 2; ++i) { ck[2 + i] = *(const u32x4*)(kcmp + (size_t)(64 + srow + 32 * i) * 128 + 8 * sch); cv[2 + i] = *(const u32x4*)(vcmp + (size_t)(64 + srow + 32 * i) * 128 + 8 * sch); }
        }
        __builtin_amdgcn_sched_barrier(0);
        lutl[tid] = l0 * 1.4426950408889634f; lutl[tid + NTHREADS] = l1 * 1.4426950408889634f;
        if (tid == 0) misc[0] = 0u;
#pragma unroll
        for (int s = 0; s < 8; ++s) *(LAS bf16x8*)(Ql + (s * 64 + lane) * 16) = qv[s];
#pragma unroll
        for (int i = 0; i < 2; ++i) { *(LAS u32x4*)(Kl + offb(srow + 32 * i, sch)) = ck[i]; *(LAS u32x4*)(Vl + offb(srow + 32 * i, sch)) = cv[i]; }
        if (ntile == 2) {
#pragma unroll
            for (int i = 0; i < 2; ++i) { *(LAS u32x4*)(lds + L_K2 + offb(srow + 32 * i, sch)) = ck[2 + i]; *(LAS u32x4*)(lds + L_V2 + offb(srow + 32 * i, sch)) = cv[2 + i]; }
        }
    }
    const float g0 = 1.f / (1.f + __expf(-bf2f(gr0))), g1 = 1.f / (1.f + __expf(-bf2f(gr1))), g2 = 1.f / (1.f + __expf(-bf2f(gr2)));
    const rsrc_t otr = mk_rsrc(P.ws + ((blockIdx.x & 128u) ? WS_NSCR1 : WS_NSCR0) + (size_t)(blockIdx.x & 127u) * 262144, 262144);
    const unsigned otv = (unsigned)(wid * 16384 + lane * 16);
    unsigned selmask;
    u32x4 sk0, sk1, sv0, sv1;
    {
        ldsb* K2l = lds + L_K2; ldsb* V2l = lds + L_V2;
        __syncthreads();
        f32x16 pa0, pa1, pb0, pb1;
#pragma unroll
        for (int r = 0; r < 16; ++r) { pa0[r] = 0.f; pa1[r] = 0.f; pb0[r] = 0.f; pb1[r] = 0.f; }
        qk128l(pa0, pa1, Kl, Ql, lane, r32, hi);
        if (ntile == 2) qk128l(pb0, pb1, K2l, Ql, lane, r32, hi);
        float tmax = NEGF;
#define CMP_BIAS(P0, P1, TI) { int tb = t - 31 - 16 * (64 * (TI) + 4 * hi); asm volatile("" : "+v"(tb)); \
            _Pragma("unroll") for (int r = 0; r < 16; ++r) { \
                const int d0 = tb - 16 * ((r & 3) + 8 * (r >> 2)), d1 = d0 - 512; \
                const int i0 = d0 < 0 ? 0 : (d0 > 127 ? 127 : d0), i1 = d1 < 0 ? 0 : (d1 > 127 ? 127 : d1); \
                float b0 = lutl[i0 * 8 + hh], b1 = lutl[i1 * 8 + hh]; asm volatile("" : "+v"(b0), "+v"(b1)); \
                P0[r] = (d0 >= 0) ? P0[r] + b0 : NEGF; P1[r] = (d1 >= 0) ? P1[r] + b1 : NEGF; \
                tmax = fmaxf(tmax, fmaxf(P0[r], P1[r])); } }
        CMP_BIAS(pa0, pa1, 0)
        if (ntile == 2) { CMP_BIAS(pb0, pb1, 1) } else {
#pragma unroll
            for (int r = 0; r < 16; ++r) { pb0[r] = NEGF; pb1[r] = NEGF; }
        }
#undef CMP_BIAS
        tmax = fmaxf(tmax, __shfl_xor(tmax, 32));
        const float m = tmax;
        float l = 0.f;
#define CMP_EXP(P) { _Pragma("unroll") for (int r = 0; r < 16; ++r) { const float e = __builtin_amdgcn_exp2f(fminf(P[r] - m, 0.f)); P[r] = (P[r] > -1e29f) ? e : 0.f; l += P[r]; } }
        CMP_EXP(pa0) CMP_EXP(pa1) CMP_EXP(pb0) CMP_EXP(pb1)
#undef CMP_EXP
        l += __shfl_xor(l, 32);
        const float inv = 1.f / fmaxf(l, 1e-30f);
#pragma unroll
        for (int r = 0; r < 16; ++r) { pa0[r] *= inv; pa1[r] *= inv; pb0[r] *= inv; pb1[r] *= inv; }
        f32x16 o[4];
#pragma unroll
        for (int c = 0; c < 4; ++c)
#pragma unroll
            for (int r = 0; r < 16; ++r) o[c][r] = 0.f;
        float A[4][4], Lv[4][4];
#pragma unroll
        for (int gq = 0; gq < 4; ++gq) {
            Lv[0][gq] = 0.5f * pa0[4 * gq + 3]; A[0][gq] = (pa0[4 * gq] + pa0[4 * gq + 1]) + (pa0[4 * gq + 2] + Lv[0][gq]);
            Lv[1][gq] = 0.5f * pa1[4 * gq + 3]; A[1][gq] = (pa1[4 * gq] + pa1[4 * gq + 1]) + (pa1[4 * gq + 2] + Lv[1][gq]);
            Lv[2][gq] = 0.5f * pb0[4 * gq + 3]; A[2][gq] = (pb0[4 * gq] + pb0[4 * gq + 1]) + (pb0[4 * gq + 2] + Lv[2][gq]);
            Lv[3][gq] = 0.5f * pb1[4 * gq + 3]; A[3][gq] = (pb1[4 * gq] + pb1[4 * gq + 1]) + (pb1[4 * gq + 2] + Lv[3][gq]);
        }
        pv128(o, pa0, pa1, Vl, lane);
        if (ntile == 2) pv128(o, pb0, pb1, V2l, lane);
        {
            const bf16_t* skb = proj + (size_t)b * SEQ * NPAD + C_KV + (2 * 2 + g) * 128 + (size_t)(tid >> 4) * NPAD + 8 * (tid & 15);
            const bf16_t* svb = proj + (size_t)b * SEQ * NPAD + C_KV + (3 * 2 + g) * 128 + (size_t)(tid >> 4) * NPAD + 8 * (tid & 15);
            sk0 = *(const u32x4*)(skb); sk1 = *(const u32x4*)(skb + (size_t)32 * NPAD);
            sv0 = *(const u32x4*)(svb); sv1 = *(const u32x4*)(svb + (size_t)32 * NPAD);
        }
        acc_rows<0>(otr, otv, o, g0, wsf, r32, hi);
        if (qi < 16) {
            selmask = (1u << (qi + 1)) - 1u;
        } else {
            float imp[4][4];
#pragma unroll
            for (int i = 0; i < 4; ++i)
#pragma unroll
                for (int gq = 0; gq < 4; ++gq) {
                    const float rc = __shfl_xor(Lv[i][gq], 32);
                    float prev_for_hi0;
                    if (gq > 0) prev_for_hi0 = __shfl_xor(Lv[i][gq - 1], 32);
                    else if (i > 0) prev_for_hi0 = __shfl_xor(Lv[i - 1][3], 32);
                    else prev_for_hi0 = 0.f;
                    imp[i][gq] = A[i][gq] + (hi ? rc : prev_for_hi0);
                }
#pragma unroll
            for (int i = 0; i < 4; ++i)
#pragma unroll
                for (int gq = 0; gq < 4; ++gq) { float v = imp[i][gq]; v += __shfl_xor(v, 8); v += __shfl_xor(v, 16); imp[i][gq] = v; }
#pragma unroll
            for (int i = 0; i < 4; ++i)
#pragma unroll
                for (int gq = 0; gq < 4; ++gq) {
                    const int j = 8 * i + 2 * gq + hi;
                    float v = imp[i][gq];
                    if (j == 0 || j == qi || j == qi - 1) v = 1e9f;
                    if (j > qi) v = -1e9f;
                    imp[i][gq] = v;
                }
            float oth[4][4];
#pragma unroll
            for (int i = 0; i < 4; ++i)
#pragma unroll
                for (int gq = 0; gq < 4; ++gq) oth[i][gq] = __shfl_xor(imp[i][gq], 32);
            unsigned bits = 0u;
            int headv = head, hiv = hi; asm volatile("" : "+v"(headv), "+v"(hiv));
#pragma unroll
            for (int gq = 0; gq < 4; ++gq) {
                const unsigned m0 = (unsigned)(-(int)(headv == 0)), m1 = (unsigned)(-(int)(headv == 1)), m2 = (unsigned)(-(int)(headv == 2)), m3 = (unsigned)(-(int)(headv == 3));
                const float x = __builtin_bit_cast(float, (__builtin_bit_cast(unsigned, imp[0][gq]) & m0) | (__builtin_bit_cast(unsigned, imp[1][gq]) & m1) |
                                                          (__builtin_bit_cast(unsigned, imp[2][gq]) & m2) | (__builtin_bit_cast(unsigned, imp[3][gq]) & m3));
                const int j = 8 * headv + 2 * gq + hiv;
                int rank = 0;
#pragma unroll
                for (int i2 = 0; i2 < 4; ++i2)
#pragma unroll
                    for (int g2q = 0; g2q < 4; ++g2q) {
                        const int jm = 8 * i2 + 2 * g2q + hiv, jo = 8 * i2 + 2 * g2q + (1 - hiv);
                        const float vm = imp[i2][g2q], vo = oth[i2][g2q];
                        rank += (vm > x || (vm == x && jm < j)) ? 1 : 0;
                        rank += (vo > x || (vo == x && jo < j)) ? 1 : 0;
                    }
                if (rank < 16 && j <= qi) bits |= (1u << j);
            }
            bits |= __shfl_xor(bits, 8); bits |= __shfl_xor(bits, 16); bits |= __shfl_xor(bits, 32);
            selmask = bits;
        }
    }
    atomicOr((unsigned*)misc, selmask);
    __syncthreads();
    const unsigned wgmask = misc[0];
    u32x4 wk0, wk1, wv0, wv1;
    {
        f32x16 o[4];
#pragma unroll
        for (int c = 0; c < 4; ++c)
#pragma unroll
            for (int r = 0; r < 16; ++r) o[c][r] = 0.f;
        float m = NEGF, l = 0.f;
        const bf16_t* kb = proj + (size_t)b * SEQ * NPAD + C_KV + (2 * 2 + g) * 128;
        const bf16_t* vb = proj + (size_t)b * SEQ * NPAD + C_KV + (3 * 2 + g) * 128;
        const bf16_t* ks0 = kb + (size_t)(tid >> 4) * NPAD + 8 * (tid & 15); const bf16_t* vs0 = vb + (size_t)(tid >> 4) * NPAD + 8 * (tid & 15);
        unsigned rem = wgmask & ((qi == 31) ? 0xffffffffu : ((2u << qi) - 1u));
        int j = 0;
        u32x4 kr0 = sk0, kr1 = sk1, vr0 = sv0, vr1 = sv1;
        const unsigned lo0 = offb(tid >> 4, tid & 15), lo1 = offb(32 + (tid >> 4), tid & 15);
        rem &= rem - 1u;
        __syncthreads();
        *(LAS u32x4*)(Kl + lo0) = kr0; *(LAS u32x4*)(Kl + lo1) = kr1; *(LAS u32x4*)(Vl + lo0) = vr0; *(LAS u32x4*)(Vl + lo1) = vr1;
        int jc = 0, cur = 0;
        if (rem) {
            j = __builtin_ctz(rem);
            kr0 = *(const u32x4*)(ks0 + (size_t)(64 * j) * NPAD); kr1 = *(const u32x4*)(ks0 + (size_t)(64 * j + 32) * NPAD);
            vr0 = *(const u32x4*)(vs0 + (size_t)(64 * j) * NPAD); vr1 = *(const u32x4*)(vs0 + (size_t)(64 * j + 32) * NPAD);
        }
        for (;;) {
            __syncthreads();
            const bool more = rem != 0u; const int jn = j;
            ldsb* Kc = cur ? lds + L_K2 : Kl; ldsb* Vc = cur ? lds + L_V2 : Vl;
            if (more) {
                rem &= rem - 1u;
                ldsb* Kn = cur ? Kl : lds + L_K2; ldsb* Vn = cur ? Vl : lds + L_V2;
                *(LAS u32x4*)(Kn + lo0) = kr0; *(LAS u32x4*)(Kn + lo1) = kr1; *(LAS u32x4*)(Vn + lo0) = vr0; *(LAS u32x4*)(Vn + lo1) = vr1;
                if (rem) {
                    j = __builtin_ctz(rem);
                    kr0 = *(const u32x4*)(ks0 + (size_t)(64 * j) * NPAD); kr1 = *(const u32x4*)(ks0 + (size_t)(64 * j + 32) * NPAD);
                    vr0 = *(const u32x4*)(vs0 + (size_t)(64 * j) * NPAD); vr1 = *(const u32x4*)(vs0 + (size_t)(64 * j + 32) * NPAD);
                }
            }
            attn_step<0>(o, m, l, Kc, Vc, Ql, lutl, wsf, t, 64 * jc, hh, ((selmask >> jc) & 1u) != 0u, lane, r32, hi);
            if (!more) break;
            jc = jn; cur ^= 1;
        }
        {
            const bf16_t* wkb = proj + (size_t)b * SEQ * NPAD + C_KV + (4 * 2 + g) * 128 + (size_t)(tid >> 4) * NPAD + 8 * (tid & 15);
            const bf16_t* wvb = proj + (size_t)b * SEQ * NPAD + C_KV + (5 * 2 + g) * 128 + (size_t)(tid >> 4) * NPAD + 8 * (tid & 15);
            const int jw = (qi > 8 ? qi - 8 : 0);
            wk0 = *(const u32x4*)(wkb + (size_t)(64 * jw) * NPAD); wk1 = *(const u32x4*)(wkb + (size_t)(64 * jw + 32) * NPAD);
            wv0 = *(const u32x4*)(wvb + (size_t)(64 * jw) * NPAD); wv1 = *(const u32x4*)(wvb + (size_t)(64 * jw + 32) * NPAD);
        }
        l += __shfl_xor(l, 32);
        acc_rows<1>(otr, otv, o, g1 / fmaxf(l, 1e-30f), wsf, r32, hi);
    }
    f32x16 ot[4];
    float ogv[4][4];
    {
        f32x16 (&o)[4] = ot;
#pragma unroll
        for (int c = 0; c < 4; ++c)
#pragma unroll
            for (int r = 0; r < 16; ++r) o[c][r] = 0.f;
        float m = NEGF, l = 0.f;
        const bf16_t* kb = proj + (size_t)b * SEQ * NPAD + C_KV + (4 * 2 + g) * 128;
        const bf16_t* vb = proj + (size_t)b * SEQ * NPAD + C_KV + (5 * 2 + g) * 128;
        const bf16_t* ks0 = kb + (size_t)(tid >> 4) * NPAD + 8 * (tid & 15); const bf16_t* vs0 = vb + (size_t)(tid >> 4) * NPAD + 8 * (tid & 15);
        int j = (qi > 8 ? qi - 8 : 0);
        u32x4 kr0 = wk0, kr1 = wk1, vr0 = wv0, vr1 = wv1;
        const unsigned lo0 = offb(tid >> 4, tid & 15), lo1 = offb(32 + (tid >> 4), tid & 15);
        __syncthreads();
        *(LAS u32x4*)(Kl + lo0) = kr0; *(LAS u32x4*)(Kl + lo1) = kr1; *(LAS u32x4*)(Vl + lo0) = vr0; *(LAS u32x4*)(Vl + lo1) = vr1;
        if (j < qi) {
            kr0 = *(const u32x4*)(ks0 + (size_t)(64 * j + 64) * NPAD); kr1 = *(const u32x4*)(ks0 + (size_t)(64 * j + 96) * NPAD);
            vr0 = *(const u32x4*)(vs0 + (size_t)(64 * j + 64) * NPAD); vr1 = *(const u32x4*)(vs0 + (size_t)(64 * j + 96) * NPAD);
        }
        for (int cur = 0; ; ++j, cur ^= 1) {
            __syncthreads();
            ldsb* Kc = cur ? lds + L_K2 : Kl; ldsb* Vc = cur ? lds + L_V2 : Vl;
            if (j < qi) {
                ldsb* Kn = cur ? Kl : lds + L_K2; ldsb* Vn = cur ? Vl : lds + L_V2;
                *(LAS u32x4*)(Kn + lo0) = kr0; *(LAS u32x4*)(Kn + lo1) = kr1; *(LAS u32x4*)(Vn + lo0) = vr0; *(LAS u32x4*)(Vn + lo1) = vr1;
                if (j + 1 < qi) {
                    kr0 = *(const u32x4*)(ks0 + (size_t)(64 * j + 128) * NPAD); kr1 = *(const u32x4*)(ks0 + (size_t)(64 * j + 160) * NPAD);
                    vr0 = *(const u32x4*)(vs0 + (size_t)(64 * j + 128) * NPAD); vr1 = *(const u32x4*)(vs0 + (size_t)(64 * j + 160) * NPAD);
                }
            }
            attn_step<1>(o, m, l, Kc, Vc, Ql, lutl, wsf, t, 64 * j, hh, true, lane, r32, hi);
            if (j >= qi) break;
        }
        l += __shfl_xor(l, 32);
        {
            const float* og = P.nsa_out_g;
#pragma unroll
            for (int hq = 0; hq < 4; ++hq)
#pragma unroll
                for (int c = 0; c < 4; ++c) ogv[hq][c] = og[(g * 4 + hq) * 128 + 32 * c + r32];
        }
        acc_rows<2>(otr, otv, o, g2 / fmaxf(l, 1e-30f), wsf, r32, hi);
    }
#pragma unroll
    for (int r = 0; r < 16; ++r) {
        float ss = (ot[0][r] * ot[0][r] + ot[1][r] * ot[1][r]) + (ot[2][r] * ot[2][r] + ot[3][r] * ot[3][r]);
        ss = half_sum(ss);
        const float rstd = rsqrtf(ss * (1.f / 128.f) + EPS);
        const int q = crow(r, hi), hq = q >> 3, tq = 64 * qi + 8 * wid + (q & 7);
        const size_t orow = (size_t)b * SEQ + tq;
#pragma unroll
        for (int c = 0; c < 4; ++c) {
            const int col = (g * 4 + hq) * 128 + 32 * c + r32;
            mix[orow * DM + 1024 + col] = (bf16_t)f2bf(ot[c][r] * rstd * ogv[r >> 2][c]);
        }
    }
}
DI unsigned f2sort(float f) { const unsigned u = __builtin_bit_cast(unsigned, f); return u ^ ((u >> 31) ? 0xffffffffu : 0x80000000u); }
DI float sort2f(unsigned s) { const unsigned u = s ^ ((s >> 31) ? 0x80000000u : 0xffffffffu); return __builtin_bit_cast(float, u); }
DI void ce_desc(unsigned& a, unsigned& b) { const unsigned t = a > b ? a : b; b = a > b ? b : a; a = t; }
template <int J> DI void bitonic_pass16(unsigned (&x)[16]) {
#pragma unroll
    for (int i = 0; i < 16; ++i) if ((i ^ J) > i) ce_desc(x[i], x[i ^ J]);
}
template <int K, int J> DI void bitonic_pass16k(unsigned (&x)[16]) {
#pragma unroll
    for (int i = 0; i < 16; ++i) if ((i ^ J) > i) { if ((i & K) == 0) ce_desc(x[i], x[i ^ J]); else ce_desc(x[i ^ J], x[i]); }
}
DI void bitonic_sort16(unsigned (&x)[16]) {
    bitonic_pass16k<2, 1>(x);
    bitonic_pass16k<4, 2>(x); bitonic_pass16k<4, 1>(x);
    bitonic_pass16k<8, 4>(x); bitonic_pass16k<8, 2>(x); bitonic_pass16k<8, 1>(x);
    bitonic_pass16<8>(x); bitonic_pass16<4>(x); bitonic_pass16<2>(x); bitonic_pass16<1>(x);
}
DI void bitonic_merge16(unsigned (&x)[16]) { bitonic_pass16<8>(x); bitonic_pass16<4>(x); bitonic_pass16<2>(x); bitonic_pass16<1>(x); }
DI void merge_top16(unsigned (&t)[16], const unsigned (&o)[16]) {
#pragma unroll
    for (int i = 0; i < 16; ++i) t[i] = t[i] > o[15 - i] ? t[i] : o[15 - i];
    bitonic_merge16(t);
}
template <int N> DI void merge_topN(unsigned (&t)[16], const unsigned (&o)[N]) {
#pragma unroll
    for (int i = 16 - N; i < 16; ++i) t[i] = t[i] > o[15 - i] ? t[i] : o[15 - i];
    bitonic_merge16(t);
}

DI void peer_stage(ldsb* lds, const Ptrs& P, int tid) {
    const bf16_t* skb = (const bf16_t*)(P.ws + WS_TAB + TAB_SK);
    const f32x4 g2r = *(const f32x4*)(P.norm2_g + 4 * tid), gfr = *(const f32x4*)(P.norm_f_g + 4 * tid);
    u32x4 skr[8];
#pragma unroll
    for (int i = 0; i < 8; ++i) { const int ci = tid + 512 * i; skr[i] = *(const u32x4*)(skb + (size_t)(ci >> 4) * 128 + 8 * (ci & 15)); }
    *(LAS f32x4*)(lds + L_G2 + tid * 16) = g2r;
    *(LAS f32x4*)(lds + L_GF + tid * 16) = gfr;
#pragma unroll
    for (int i = 0; i < 8; ++i) { const int ci = tid + 512 * i; *(LAS u32x4*)(lds + L_SK + offb(ci >> 4, ci & 15)) = skr[i]; }
}
DI void peer_tile(ldsb* lds, const Ptrs& P, int tile, int tid, bool first) {
    const int lane = tid & 63, wid = __builtin_amdgcn_readfirstlane(tid >> 6), r32 = lane & 31, hi = lane >> 5;
    const bf16_t* qpeer = (const bf16_t*)(P.ws + WS_PROJ);
    const bf16_t* skb = (const bf16_t*)(P.ws + WS_TAB + TAB_SK);
    const unsigned char* ub = P.ws + WS_UB; const unsigned char* vb = P.ws + WS_VB;
    const f32x2_t* uvinv = (const f32x2_t*)(P.ws + WS_TAB + TAB_UINV);
    const float* ssq = (const float*)(P.ws + WS_CTL + CTL_SSQ);
    float* hout = P.out;
    const int tok0 = tile * 32;
    LAS unsigned* elist = (LAS unsigned*)(lds + L_EL); LAS float* glist = (LAS float*)(lds + L_GL); LAS float* ulist = (LAS float*)(lds + L_UL);
    LAS unsigned char* idxs = (LAS unsigned char*)(lds + L_IDX) + wid * 1024;
    bf16x8 qfa[2][8];
    {
        const bf16_t* qp = qpeer + (size_t)(tok0 + r32) * DM + wid * 256 + 8 * hi;
#pragma unroll
        for (int p = 0; p < 2; ++p)
#pragma unroll
            for (int s = 0; s < 8; ++s) qfa[p][s] = *(const bf16x8*)(qp + p * 128 + 16 * s);
    }
    __syncthreads();
    if (first) { peer_stage(lds, P, tid); __syncthreads(); }
    unsigned ta[16], tb[16];
#pragma unroll
    for (int p = 0; p < 2; ++p) {
        f32x16 sc[4];
#pragma unroll
        for (int i = 0; i < 4; ++i)
#pragma unroll
            for (int r = 0; r < 16; ++r) sc[i][r] = 0.f;
        bf16x8 qf[8];
#pragma unroll
        for (int s = 0; s < 8; ++s) qf[s] = qfa[p][s];
#pragma unroll
        for (int kt = 0; kt < 4; ++kt) {
#pragma unroll
            for (int s = 0; s < 8; ++s) {
                const bf16x8 a = *(LAS bf16x8*)(lds + L_SK + offb(p * 128 + 32 * kt + r32, 2 * s + hi));
                sc[kt] = MFMA32(a, qf[s], sc[kt]);
            }
            __builtin_amdgcn_sched_barrier(0);
        }
        unsigned top[16];
        {
            unsigned l1[16], l2[16], l3[16];
#pragma unroll
            for (int r = 0; r < 16; ++r) {
                top[r] = (f2sort(sc[0][r]) & ~127u) | (unsigned)(crow(r, hi));
                l1[r] = (f2sort(sc[1][r]) & ~127u) | (unsigned)(32 + crow(r, hi));
                l2[r] = (f2sort(sc[2][r]) & ~127u) | (unsigned)(64 + crow(r, hi));
                l3[r] = (f2sort(sc[3][r]) & ~127u) | (unsigned)(96 + crow(r, hi));
            }
            bitonic_sort16(top); bitonic_sort16(l1); merge_top16(top, l1);
            bitonic_sort16(l2); bitonic_sort16(l3); merge_top16(l2, l3);
            merge_top16(top, l2);
        }
        unsigned oth[16];
#pragma unroll
        for (int k = 0; k < 16; ++k) oth[k] = (unsigned)__builtin_amdgcn_ds_bpermute((lane ^ 32) << 2, (int)top[k]);
        merge_top16(top, oth);
#pragma unroll
        for (int k = 0; k < 16; ++k) { if (p == 0) ta[k] = top[k]; else tb[k] = top[k]; }
    }
    unsigned ct[16];
    {
        float va[16], vb2[16];
#pragma unroll
        for (int k = 0; k < 16; ++k) { va[k] = sort2f(ta[k] & ~127u); vb2[k] = sort2f(tb[k] & ~127u); }
#define CKEY(i, j) ((f2sort(va[i] + vb2[j]) & ~255u) | (unsigned)(255 - ((i) * 16 + (j))))
#pragma unroll
        for (int j = 0; j < 16; ++j) ct[j] = CKEY(0, j);
        { unsigned r[8]; _Pragma("unroll") for (int j = 0; j < 8; ++j) r[j] = CKEY(1, j); merge_topN<8>(ct, r); }
        { unsigned r[5]; _Pragma("unroll") for (int j = 0; j < 5; ++j) r[j] = CKEY(2, j); merge_topN<5>(ct, r); }
        { unsigned r[4]; _Pragma("unroll") for (int j = 0; j < 4; ++j) r[j] = CKEY(3, j); merge_topN<4>(ct, r); }
        { unsigned r[3]; _Pragma("unroll") for (int j = 0; j < 3; ++j) r[j] = CKEY(4, j); merge_topN<3>(ct, r); }
        { unsigned r[2]; r[0] = CKEY(5, 0); r[1] = CKEY(5, 1); merge_topN<2>(ct, r); }
        { unsigned r[2]; r[0] = CKEY(6, 0); r[1] = CKEY(6, 1); merge_topN<2>(ct, r); }
        { unsigned r[2]; r[0] = CKEY(7, 0); r[1] = CKEY(7, 1); merge_topN<2>(ct, r); }
        { unsigned r[8]; _Pragma("unroll") for (int i = 0; i < 8; ++i) r[i] = CKEY(8 + i, 0); merge_topN<8>(ct, r); }
#undef CKEY
    }
    if (hi == 0) {
#pragma unroll
        for (int k = 0; k < 16; ++k) { idxs[r32 * 32 + k] = (unsigned char)(ta[k] & 127u); idxs[r32 * 32 + 16 + k] = (unsigned char)(tb[k] & 127u); }
    }
    asm volatile("s_waitcnt lgkmcnt(0)" ::: "memory");
    {
        float cs[16]; float mx, sum = 0.f;
#pragma unroll
        for (int k = 0; k < 16; ++k) cs[k] = sort2f(ct[k] & ~255u);
        mx = cs[0];
#pragma unroll
        for (int k = 0; k < 16; ++k) { cs[k] = __expf(cs[k] - mx); sum += cs[k]; }
        const float inv = 1.f / sum;
        unsigned ev[8]; float gvv[8], vsc[8], usc[8];
#pragma unroll
        for (int k = 0; k < 8; ++k) {
            const unsigned hm = (unsigned)(-hi);
            const unsigned key = (ct[k + 8] & hm) | (ct[k] & ~hm);
            gvv[k] = __builtin_bit_cast(float, (__builtin_bit_cast(unsigned, cs[k + 8]) & hm) | (__builtin_bit_cast(unsigned, cs[k]) & ~hm)) * inv;
            const unsigned cidx = 255u - (key & 255u), ii = cidx >> 4, jj = cidx & 15u;
            ev[k] = (unsigned)idxs[r32 * 32 + ii] * 128u + (unsigned)idxs[r32 * 32 + 16 + jj];
        }
#pragma unroll
        for (int k = 0; k < 8; ++k) { const f32x2_t uv2 = uvinv[ev[k]]; usc[k] = uv2.x; vsc[k] = uv2.y; }
#pragma unroll
        for (int k = 0; k < 8; ++k) {
            const int slot = r32 * 128 + wid * 16 + k + 8 * hi;
            elist[slot] = ev[k]; glist[slot] = gvv[k] * vsc[k]; ulist[slot] = usc[k];
        }
    }
    __syncthreads();
    const rsrc_t rs_o = mk_rsrc(hout + (size_t)tok0 * DM, 32 * DM * 4);
    const rsrc_t rs_hb = mk_rsrc((const bf16_t*)(P.ws + WS_XB) + (size_t)tok0 * DM, 32 * DM * 2);
    const unsigned lv64 = (unsigned)(lane * 64);
    const rsrc_t rs_u = mk_rsrc(ub, 16384 * (DM / 2)), rs_v = mk_rsrc(vb, 16384 * (DM / 2)); const unsigned lv16 = (unsigned)(lane * 16);
    unsigned eA[PB], eB[PB]; float gA[PB], gB[PB], sA[PB], sB[PB]; u32x4 uA[PB], vA[PB], uB[PB], vB[PB];
    auto issue = [&](unsigned (&e)[PB], float (&gt)[PB], float (&us)[PB], u32x4 (&uq)[PB], u32x4 (&vq)[PB], int tl_, int k_) {
#pragma unroll
        for (int kk = 0; kk < PB; ++kk) {
            e[kk] = (unsigned)__builtin_amdgcn_readfirstlane((int)elist[tl_ * 128 + k_ + kk]);
            gt[kk] = __builtin_bit_cast(float, __builtin_amdgcn_readfirstlane(__builtin_bit_cast(int, glist[tl_ * 128 + k_ + kk])));
            us[kk] = __builtin_bit_cast(float, __builtin_amdgcn_readfirstlane(__builtin_bit_cast(int, ulist[tl_ * 128 + k_ + kk])));
        }
#pragma unroll
        for (int kk = 0; kk < PB; ++kk) uq[kk] = bld128(rs_u, lv16, e[kk] * (unsigned)(DM / 2));
#pragma unroll
        for (int kk = 0; kk < PB; ++kk) vq[kk] = bld128(rs_v, lv16, e[kk] * (unsigned)(DM / 2));
        __builtin_amdgcn_sched_barrier(0);
    };
    u32x2 hbn[8]; float ssqn = ssq[(size_t)tok0 + 4 * wid];
#pragma unroll
    for (int q = 0; q < 8; ++q) hbn[q] = __builtin_amdgcn_raw_buffer_load_b64(rs_hb, (int)(lane * 8 + q * 512), (int)(4 * wid * DM * 2), 0);
    issue(eA, gA, sA, uA, vA, 4 * wid, 0);
    for (int tt = 0; tt < 4; ++tt) {
        const int tl = 4 * wid + tt; const size_t row = (size_t)tok0 + tl;
        const unsigned hso = (unsigned)(tl * DM * 4);
        unsigned xb[16]; f32x2_t acc[16];
        u32x2 hbp[8];
        const float rs2 = rsqrtf(ssqn * (1.f / DM) + EPS);
#pragma unroll
        for (int q = 0; q < 8; ++q) hbp[q] = hbn[q];
        {
            const int ntl = (tt < 3) ? tl + 1 : tl;
            ssqn = ssq[(size_t)tok0 + ntl];
#pragma unroll
            for (int q = 0; q < 8; ++q) hbn[q] = __builtin_amdgcn_raw_buffer_load_b64(rs_hb, (int)(lane * 8 + q * 512), (int)(ntl * DM * 2), 0);
        }
#pragma unroll
        for (int q = 0; q < 8; ++q) {
            const u32x2 hv = hbp[q];
            const f32x4 ga = *(LAS f32x4*)(lds + L_G2 + (q * 64 + lane) * 16);
            xb[2 * q] = cvtpk(bflo(hv.x) * rs2 * ga[0], bfhi(hv.x) * rs2 * ga[1]); xb[2 * q + 1] = cvtpk(bflo(hv.y) * rs2 * ga[2], bfhi(hv.y) * rs2 * ga[3]);
            acc[2 * q] = f32x2_t{0.f, 0.f}; acc[2 * q + 1] = f32x2_t{0.f, 0.f};
        }
#define PEER_U4(W) { d0 = __builtin_amdgcn_fdot2_f32_bf16(__builtin_amdgcn_cvt_scalef32_pk_bf16_fp4(uq[kk][W], 1.0f, 0), __builtin_bit_cast(bf16x2_t, xb[4 * W]), d0, false); \
                     d1 = __builtin_amdgcn_fdot2_f32_bf16(__builtin_amdgcn_cvt_scalef32_pk_bf16_fp4(uq[kk][W], 1.0f, 1), __builtin_bit_cast(bf16x2_t, xb[4 * W + 1]), d1, false); \
                     d0 = __builtin_amdgcn_fdot2_f32_bf16(__builtin_amdgcn_cvt_scalef32_pk_bf16_fp4(uq[kk][W], 1.0f, 2), __builtin_bit_cast(bf16x2_t, xb[4 * W + 2]), d0, false); \
                     d1 = __builtin_amdgcn_fdot2_f32_bf16(__builtin_amdgcn_cvt_scalef32_pk_bf16_fp4(uq[kk][W], 1.0f, 3), __builtin_bit_cast(bf16x2_t, xb[4 * W + 3]), d1, false); }
#define PEER_V4(W) { acc[4 * W] = __builtin_elementwise_fma(h2, __builtin_amdgcn_cvt_scalef32_pk_f32_fp4(vq[kk][W], 1.0f, 0), acc[4 * W]); \
                     acc[4 * W + 1] = __builtin_elementwise_fma(h2, __builtin_amdgcn_cvt_scalef32_pk_f32_fp4(vq[kk][W], 1.0f, 1), acc[4 * W + 1]); \
                     acc[4 * W + 2] = __builtin_elementwise_fma(h2, __builtin_amdgcn_cvt_scalef32_pk_f32_fp4(vq[kk][W], 1.0f, 2), acc[4 * W + 2]); \
                     acc[4 * W + 3] = __builtin_elementwise_fma(h2, __builtin_amdgcn_cvt_scalef32_pk_f32_fp4(vq[kk][W], 1.0f, 3), acc[4 * W + 3]); }
        auto consume = [&](const float (&gt)[PB], const float (&us)[PB], u32x4 (&uq)[PB], u32x4 (&vq)[PB]) {
            float dot[PB];
#pragma unroll
            for (int kk = 0; kk < PB; ++kk) {
                float d0 = 0.f, d1 = 0.f;
                if (kk > 0) asm volatile("" : "+v"(uq[kk]), "+v"(dot[kk - 1]));
                PEER_U4(0) PEER_U4(1) PEER_U4(2) PEER_U4(3)
                dot[kk] = d0 + d1;
                __builtin_amdgcn_sched_barrier(0);
            }
#pragma unroll
            for (int kk = 0; kk < PB; ++kk) dot[kk] = wave_sum_u(dot[kk]);
            float hv[PB];
#pragma unroll
            for (int kk = 0; kk < PB; ++kk) hv[kk] = gelu_tanh(dot[kk] * us[kk]) * gt[kk];
            __builtin_amdgcn_sched_barrier(0);
#pragma unroll
            for (int kk = 0; kk < PB; ++kk) {
                asm volatile("" : "+v"(vq[kk]), "+v"(acc[0]), "+v"(acc[15]));
                const f32x2_t h2 = {hv[kk], hv[kk]};
                PEER_V4(0) PEER_V4(1) PEER_V4(2) PEER_V4(3)
                __builtin_amdgcn_sched_barrier(0);
            }
        };
#pragma unroll 1
        for (int k0 = 0; k0 < 128; k0 += 2 * PB) {
            issue(eB, gB, sB, uB, vB, tl, k0 + PB);
            consume(gA, sA, uA, vA);
            {
                int ntl = tl, nk = k0 + 2 * PB;
                if (nk >= 128) { ntl = (tt < 3) ? tl + 1 : tl; nk = 0; }
                issue(eA, gA, sA, uA, vA, ntl, nk);
            }
            consume(gB, sB, uB, vB);
        }
        float ss = 0.f;
#pragma unroll
        for (int q = 0; q < 8; ++q) {
            const u32x2 hv = hbp[q];
            acc[2 * q].x += bflo(hv.x); acc[2 * q].y += bfhi(hv.x); acc[2 * q + 1].x += bflo(hv.y); acc[2 * q + 1].y += bfhi(hv.y);
            ss += (acc[2 * q].x * acc[2 * q].x + acc[2 * q].y * acc[2 * q].y) + (acc[2 * q + 1].x * acc[2 * q + 1].x + acc[2 * q + 1].y * acc[2 * q + 1].y);
        }
        ss = wave_sum_u(ss);
        const float rf = rsqrtf(ss * (1.f / DM) + EPS);
        f32x4 gfv[8];
#pragma unroll
        for (int q8 = 0; q8 < 8; ++q8) gfv[q8] = *(LAS f32x4*)(lds + L_GF + (q8 * 64 + lane) * 16);
#pragma unroll
        for (int q8 = 0; q8 < 8; ++q8) {
            const f32x4 gv = gfv[q8];
            gfv[q8] = f32x4{acc[2 * q8].x * rf * gv[0], acc[2 * q8].y * rf * gv[1], acc[2 * q8 + 1].x * rf * gv[2], acc[2 * q8 + 1].y * rf * gv[3]};
        }
        __builtin_amdgcn_sched_barrier(0);
#pragma unroll
        for (int q8 = 0; q8 < 8; ++q8) bstf4(rs_o, (unsigned)(lane * 16 + q8 * 1024), hso, gfv[q8]);
        asm volatile("s_nop 7" ::: "memory");
        __builtin_amdgcn_sched_barrier(0);
    }
#pragma unroll
    for (int kk = 0; kk < PB; ++kk) asm volatile("" :: "v"(uA[kk]), "v"(vA[kk]));
#pragma unroll
    for (int q = 0; q < 8; ++q) asm volatile("" :: "v"(hbn[q]));
    asm volatile("" :: "v"(ssqn));
}

typedef __attribute__((address_space(1))) unsigned gu32;
#define XB_TMO      128
#define XB_XCNT(j)  (256  + 64 * (j))
#define XB_XSUB(j)  (1280 + 64 * (j))
#define XB_XGEN(j)  (2304 + 64 * (j))
#define XB_TOP      3328
#define XB_TOPGEN   3392
#define XCD_BAR_WORDS 3456
#define XB_SPIN_CAP (1u << 18)

__device__ __forceinline__ unsigned xb_ld(unsigned* p)              { return __hip_atomic_load(p, __ATOMIC_RELAXED, __HIP_MEMORY_SCOPE_AGENT); }
__device__ __forceinline__ unsigned xb_add(unsigned* p, unsigned v) { return __hip_atomic_fetch_add(p, v, __ATOMIC_RELAXED, __HIP_MEMORY_SCOPE_AGENT); }
__device__ __forceinline__ unsigned xb_xcc_id() { return (unsigned)__builtin_amdgcn_s_getreg((3 << 11) | 20) & 0xFu; }
#define XB_SPIN(cond, bar) do { unsigned _sp = 0; while (cond) { __builtin_amdgcn_s_sleep(1); \
    if ((++_sp & 255u) == 0u) { if (xb_ld(&(bar)[XB_TMO])) break; if (_sp > XB_SPIN_CAP) { atomicAdd(&(bar)[XB_TMO], 1u); break; } } } } while (0)

struct XcdBarrier {
    unsigned* bar; unsigned x;
    volatile LAS unsigned* st;
    int w64;
};

__device__ __forceinline__ XcdBarrier xcd_barrier_post(unsigned* bar, volatile LAS unsigned* st, int w64) {
    XcdBarrier b; b.bar = bar; b.x = xb_xcc_id(); b.st = st; b.w64 = w64;
    if (w64 + lane_now() == 0) (void)xb_add(&bar[XB_XCNT(b.x)], 1u);
    return b;
}
__device__ __forceinline__ void xcd_barrier_complete(unsigned* bar, unsigned x, unsigned& nloc, unsigned& nx) {
    const unsigned G = gridDim.x * gridDim.y * gridDim.z;
    unsigned sum, cnt, mine, sp = 0u;
    for (;;) {
        sum = 0u; cnt = 0u; mine = 0u;
#pragma unroll
        for (unsigned j = 0; j < 16; ++j) { const unsigned c = xb_ld(&bar[XB_XCNT(j)]); sum += c; cnt += (c > 0u) ? 1u : 0u; mine = (j == x) ? c : mine; }
        if (sum == G) break;
        __builtin_amdgcn_s_sleep(1);
        if ((++sp & 255u) == 0u) { if (xb_ld(&bar[XB_TMO])) break; if (sp > XB_SPIN_CAP) { atomicAdd(&bar[XB_TMO], 1u); break; } }
    }
    nloc = mine > 0u ? mine : 1u; nx = cnt > 0u ? cnt : 1u;
}

__device__ __forceinline__ void xcd_barrier(const XcdBarrier& b) {
    asm volatile("s_waitcnt vmcnt(0)" ::: "memory");
    __syncthreads();
    if (b.w64 + lane_now() == 0) {
        unsigned* bar = b.bar;
        __builtin_amdgcn_s_waitcnt(0);
        unsigned nloc = b.st[0], nx = b.st[1];
        if (nloc == 0u) { xcd_barrier_complete(bar, b.x, nloc, nx); b.st[0] = nloc; b.st[1] = nx; }
        const unsigned old = xb_add(&bar[XB_XSUB(b.x)], 1u);
        const unsigned gen = old / nloc;
        if (old + 1u == (gen + 1u) * nloc) {
            __builtin_amdgcn_fence(__ATOMIC_RELEASE, "agent");
            asm volatile("s_waitcnt vmcnt(0)" ::: "memory");
            const unsigned og = xb_add(&bar[XB_TOP], 1u);
            const unsigned tg = og / nx;
            if (og + 1u == (tg + 1u) * nx) xb_add(&bar[XB_TOPGEN], 1u);
            else XB_SPIN(xb_ld(&bar[XB_TOPGEN]) == tg, bar);
            __builtin_amdgcn_fence(__ATOMIC_ACQUIRE, "agent");
            xb_add(&bar[XB_XGEN(b.x)], 1u);
            asm volatile("s_waitcnt vmcnt(0)" ::: "memory");
        } else {
            XB_SPIN(xb_ld(&bar[XB_XGEN(b.x)]) == gen, bar);
            __builtin_amdgcn_fence(__ATOMIC_ACQUIRE, "agent");
            asm volatile("s_waitcnt vmcnt(0)" ::: "memory");
        }
    }
    __syncthreads();
}
struct Args { Ptrs p; int ph_lo, ph_hi; };
constexpr int NPHASE = 7;

__global__ void __launch_bounds__(NTHREADS, 2) mega(Args args) {
    extern __shared__ __attribute__((aligned(16))) unsigned char lds_raw[];
    ldsb* lds = (ldsb*)lds_raw;
    const Ptrs P = args.p;
    const int wv64 = __builtin_amdgcn_readfirstlane((int)threadIdx.x) & ~63;
#define TIDNOW() (wv64 + lane_now())
    const int G = gridDim.x, bx = blockIdx.x;
    unsigned char* ws = P.ws;
    cg::grid_group grid = cg::this_grid();
    if (args.ph_hi > 1000) grid.sync();
    const int lo = args.ph_lo, hi = args.ph_hi;
    volatile LAS unsigned* bst = (volatile LAS unsigned*)(lds + LDS_BYTES - 64);
    { const int t0 = TIDNOW(); if (t0 < 2) bst[t0] = 0u; }
    __syncthreads();
    XcdBarrier bar = xcd_barrier_post((unsigned*)(ws + WS_CTL + 16384), bst, wv64);
#ifdef ONLY_PHASE
#define IN(k) ((k) == ONLY_PHASE && lo <= (k) && (k) < hi)
#else
#define IN(k) (lo <= (k) && (k) < hi)
#endif
#define SEAM(k) do { if (IN(k) && IN((k) + 1)) xcd_barrier(bar); } while (0)
    if (IN(0)) { phase0(P, lds, TIDNOW(), G); }
    SEAM(0);
    if (IN(1)) {
        pg8::Gemm g{(const bf16_t*)(ws + WS_XB), (const bf16_t*)(ws + WS_WIN), MTOK, NPAD, DM};
        pg8::StaticOrder S; S.init(MTOK, NPAD, G, bx);
        pg8::EpiProj E{(bf16_t*)(ws + WS_PROJ), NPAD, (const float*)(ws + WS_TAB + TAB_RS1), (const float*)(ws + WS_TAB + TAB_COS), (const float*)(ws + WS_TAB + TAB_SIN)};
        pg8::gemm_phase<pg8::EpiProj, pg8::StaticOrder, true, true>(lds, g, S, E, TIDNOW());
        if (G == 256 && bx >= 192) {
            const int tv = TIDNOW();
            convert_table_rows(P, 0, (bx - 192) * NWAVES + (tv >> 6), 64 * NWAVES, tv & 63);
        }
    }
    SEAM(1);
    if (IN(2)) {
        for (int it = bx; it < 256; it += G) { const int tv = TIDNOW(); compress_step1(lds, P, it >> 7, (it >> 3) & 15, it & 7, tv); }
        { const int tv = TIDNOW(); retention_state_units(lds, P, bx, G, tv); }
    }
    SEAM(2);
    if (IN(3)) {
        for (int it = bx; it < 128; it += G) { const int tv = TIDNOW(); compress_step2(lds, P, it >> 6, (it >> 2) & 15, it & 3, tv); }
        {
            const int u0 = (G > 128) ? bx - 128 : bx, us = (G > 128) ? G - 128 : G;
            if (u0 >= 0) for (int u = u0; u < 128; u += us) { const int tv = TIDNOW(); retention_scan_unit(P, u, tv); }
            if (G == 256) { const int tv = TIDNOW(); const int VS = 11264;
                if (bx >= 128) convert_table_rows(P, 1, (bx - 128) * NWAVES + (tv >> 6), 128 * NWAVES, tv & 63, VS);
                else convert_table_rows(P, 1, VS + bx * NWAVES + (tv >> 6), 128 * NWAVES, tv & 63, MTOK); }
        }
        xcd_barrier(bar);
    }
    if (IN(3)) {
        {
            unsigned* qb = (unsigned*)(ws + WS_CTL + CTL_QUEUE);
            volatile LAS unsigned* qslot = (volatile LAS unsigned*)(lds + LDS_BYTES - 64 + 16);
            const unsigned myx = bar.x & 7u;
            int own_empty = 0;
            for (;;) {
                const int tv = TIDNOW();
                __syncthreads();
                if (tv < 64) {
                    int res = -1;
                    if (!own_empty) {
                        unsigned k = 0u; if (tv == 0) k = __hip_atomic_fetch_add(qb + 64 * (1 + myx), 1u, __ATOMIC_RELAXED, __HIP_MEMORY_SCOPE_AGENT);
                        k = (unsigned)__builtin_amdgcn_readfirstlane((int)k);
                        if (k < 64u) res = (int)((myx << 8) | k);
                    }
                    if (res < 0) {
                        for (;;) {
                            unsigned cnt = 64u; if (tv < 8) cnt = __hip_atomic_load(qb + 64 * (1 + ((myx + (unsigned)tv) & 7u)), __ATOMIC_RELAXED, __HIP_MEMORY_SCOPE_AGENT);
                            const unsigned long long m = __ballot(cnt < 64u);
                            if (m == 0ull) break;
                            const unsigned x = (myx + (unsigned)(__ffsll((long long)m) - 1)) & 7u;
                            unsigned k = 0u; if (tv == 0) k = __hip_atomic_fetch_add(qb + 64 * (1 + x), 1u, __ATOMIC_RELAXED, __HIP_MEMORY_SCOPE_AGENT);
                            k = (unsigned)__builtin_amdgcn_readfirstlane((int)k);
                            if (k < 64u) { res = (int)((x << 8) | k); break; }
                        }
                    }
                    if (res < 0 && tv == 0) qslot[1] = __hip_atomic_fetch_add(qb, 1u, __ATOMIC_RELAXED, __HIP_MEMORY_SCOPE_AGENT);
                    if (tv == 0) qslot[0] = (unsigned)res;
                }
                __syncthreads();
                const int res = __builtin_amdgcn_readfirstlane((int)qslot[0]);
                if (res < 0) break;
                const int x = res >> 8, k = res & 255;
                if ((unsigned)x != myx) own_empty = 1;
                const int qi = 31 - (k >> 1), bg = x + 8 * (k & 1);
                nsa_unit(lds, P, bg >> 1, bg & 1, qi, tv);
            }
        }
        {
            unsigned* qctr = (unsigned*)(ws + WS_CTL + CTL_QUEUE);
            volatile LAS unsigned* qslot = (volatile LAS unsigned*)(lds + LDS_BYTES - 64 + 16);
            int it = __builtin_amdgcn_readfirstlane((int)qslot[1]);
            while (it < 512) {
                const int tv = TIDNOW();
                const int bh = it & 63, j4 = (it >> 6) & 3, jp = (it >> 8) ? 7 - j4 : j4;
                retention_out_unit(lds, P, bh >> 3, bh & 7, jp, tv);
                __syncthreads();
                if (tv == 0) qslot[0] = __hip_atomic_fetch_add(qctr, 1u, __ATOMIC_RELAXED, __HIP_MEMORY_SCOPE_AGENT);
                __syncthreads();
                it = __builtin_amdgcn_readfirstlane((int)qslot[0]);
            }
        }
    }
    SEAM(3);
    if (IN(4)) {
        pg8::Gemm g{(const bf16_t*)(ws + WS_MIX), (const bf16_t*)(ws + WS_WOUT), MTOK, DM, DM};
        pg8::StaticOrder S; S.init(MTOK, DM, G, bx);
        pg8::EpiResidual E{(const bf16_t*)(ws + WS_XB), P.out, (bf16_t*)(ws + WS_XB), (float*)(ws + WS_CTL + CTL_SSQ), DM};
        pg8::gemm_phase<pg8::EpiResidual, pg8::StaticOrder, true, true>(lds, g, S, E, TIDNOW());
    }
    SEAM(4);
    if (IN(5)) {
        pg8::Gemm g{(const bf16_t*)(ws + WS_XB), (const bf16_t*)(ws + WS_WQ), MTOK, DM, DM};
        pg8::StaticOrder S; S.init(MTOK, DM, G, bx);
        pg8::EpiRowScaleBf16 E{(bf16_t*)(ws + WS_PROJ), DM, (const float*)(ws + WS_CTL + CTL_SSQ), 1};
        pg8::gemm_phase<pg8::EpiRowScaleBf16, pg8::StaticOrder, true, true>(lds, g, S, E, TIDNOW());
    }
    const bool prestage = IN(5) && IN(6);
    if (prestage) { __syncthreads(); peer_stage(lds, P, TIDNOW()); }
    SEAM(5);
    if (IN(6)) {
        for (int it = bx; it < MTOK / 32; it += G) { const int tv = TIDNOW(); peer_tile(lds, P, it, tv, it == bx && !prestage); }
    }
#undef IN
#undef SEAM
}

extern "C" void kernel_launch(void* const* d_in, const int* in_sizes, int n_in, void* d_out, int out_size, void* d_ws, size_t ws_size, hipStream_t stream) {
    static int grid = 0;
    if (grid == 0) {
        if (n_in != 16 || out_size != MTOK * DM || ws_size < WS_END) { fprintf(stderr, "kernel_launch: unexpected shapes (n_in %d out %d ws %zu)\n", n_in, out_size, ws_size); grid = -1; return; }
        int dev = 0, cus = 0, per_cu = 0;
        hipGetDevice(&dev); hipDeviceGetAttribute(&cus, hipDeviceAttributeMultiprocessorCount, dev);
        if (hipFuncSetAttribute((const void*)mega, hipFuncAttributeMaxDynamicSharedMemorySize, LDS_BYTES) != hipSuccess) { fprintf(stderr, "kernel_launch: hipFuncSetAttribute failed\n"); grid = -1; return; }
        hipOccupancyMaxActiveBlocksPerMultiprocessor(&per_cu, (const void*)mega, NTHREADS, LDS_BYTES);
        if (per_cu < 1) { fprintf(stderr, "kernel_launch: occupancy query says %d\n", per_cu); per_cu = 1; }
        (void)hipGetLastError();
        grid = cus;
    }
    if (grid < 0) return;
    hipMemsetAsync((char*)d_ws + WS_CTL, 0, CTL_BYTES, stream);
    Args a{};
    const float** pp = (const float**)&a.p;
    for (int i = 0; i < 16; ++i) pp[i] = (const float*)d_in[i];
    a.p.out = (float*)d_out; a.p.ws = (unsigned char*)d_ws;
#if N_LAUNCHES == 1
    a.ph_lo = 0; a.ph_hi = NPHASE;
    void* kargs[] = {&a};
    hipError_t e = hipLaunchCooperativeKernel((const void*)mega, dim3(grid), dim3(NTHREADS), kargs, LDS_BYTES, stream);
    if (e != hipSuccess) fprintf(stderr, "cooperative launch failed: %s (grid %d)\n", hipGetErrorString(e), grid);
#else
    for (int ph = 0; ph < NPHASE; ++ph) {
        a.ph_lo = ph; a.ph_hi = ph + 1;
        hipLaunchKernelGGL(mega, dim3(grid), dim3(NTHREADS), LDS_BYTES, stream, a);
    }
#endif
}
```
